# Optimizing an MI355X kernel written in HIP

```python
import math
import jax, jax.numpy as jnp
from jax import lax
import numpy as np

D_MODEL = 1024
BATCH = 2
SEQ = 16384
DEPTH = 2

GRID_W = 64
CTX_LEN = 256
HEAD_DIM = 64
EPS = 1e-6
ROPE_BASE = 10000.0
ROPE_PAIRS = HEAD_DIM // 4
Q_BLOCK = 128
DA_HEADS = 4
DA_QK = 2 * HEAD_DIM
DA_V = 2 * HEAD_DIM
GLA_HEADS = 4
GLA_DK = 64
GLA_DV = 128
GLA_RANK = 16
GLA_TAU = 16.0
GLA_CHUNK = 64
NA_HEADS = 8
NA_DIM = 64
NA_KR = 8
NA_KC = 16
BR_W = 512
D_FF = 4 * D_MODEL
IN_SPLITS = (DA_HEADS * DA_QK, DA_HEADS * DA_QK, DA_HEADS * DA_V,
             GLA_HEADS * GLA_DK, GLA_HEADS * GLA_DK, GLA_HEADS * GLA_DV, GLA_HEADS * GLA_DV, 2 * GLA_RANK,
             NA_HEADS * NA_DIM, NA_HEADS * NA_DIM, NA_HEADS * NA_DIM,
             D_MODEL, D_MODEL, D_MODEL)
N_IN = sum(IN_SPLITS)

kernel_name = "hybrid_diffattn_gla_natten_prefix_block"


def rms_norm(x, g):
    xf = x.astype(jnp.float32)
    y = xf * lax.rsqrt(jnp.mean(xf * xf, axis=-1, keepdims=True) + EPS)
    return (y * g.astype(jnp.float32)).astype(x.dtype)


def to_heads(t, n_heads):
    b, n, w = t.shape
    return t.reshape(b, n, n_heads, w // n_heads).transpose(0, 2, 1, 3)


def from_heads(t):
    b, h, n, d = t.shape
    return t.transpose(0, 2, 1, 3).reshape(b, n, h * d)


def split_cols(z):
    idx = []
    acc = 0
    for s in IN_SPLITS[:-1]:
        acc += s
        idx.append(acc)
    return jnp.split(z, idx, axis=-1)


def rotate_pairs(x, ang):
    half = x.shape[-1] // 2
    x1, x2 = x[..., :half], x[..., half:]
    cos = jnp.cos(ang).astype(x.dtype)
    sin = jnp.sin(ang).astype(x.dtype)
    return jnp.concatenate([x1 * cos - x2 * sin, x1 * sin + x2 * cos], axis=-1)


def axial_rope(x, ang_row, ang_col):
    half = x.shape[-1] // 2
    return jnp.concatenate([rotate_pairs(x[..., :half], ang_row), rotate_pairs(x[..., half:], ang_col)], axis=-1)


def softmax_attend(q, k, v):
    s = jnp.einsum('bhqd,bhkd->bhqk', q, k).astype(jnp.float32)
    p = jax.nn.softmax(s, axis=-1)
    return jnp.einsum('bhqk,bhkd->bhqd', p.astype(v.dtype), v)


def da_heads(dq, dk, dv, qn_g, kn_g):
    scale = HEAD_DIM ** -0.5
    q = to_heads(dq, DA_HEADS)
    k = to_heads(dk, DA_HEADS)
    q1 = rms_norm(q[..., :HEAD_DIM], qn_g) * scale
    q2 = rms_norm(q[..., HEAD_DIM:], qn_g) * scale
    k1 = rms_norm(k[..., :HEAD_DIM], kn_g)
    k2 = rms_norm(k[..., HEAD_DIM:], kn_g)
    return q1, q2, k1, k2, to_heads(dv, DA_HEADS)


def diff_attention(q1, q2, k1, k2, v, lam, q_block):
    b, h, tq, d = q1.shape
    nb = tq // q_block

    def blocks(t):
        return t.reshape(b, h, nb, q_block, d).transpose(2, 0, 1, 3, 4)

    def one(args):
        a1, a2 = args
        p1 = jax.nn.softmax(jnp.einsum('bhqd,bhkd->bhqk', a1, k1).astype(jnp.float32), axis=-1)
        p2 = jax.nn.softmax(jnp.einsum('bhqd,bhkd->bhqk', a2, k2).astype(jnp.float32), axis=-1)
        return jnp.einsum('bhqk,bhkv->bhqv', (p1 - lam * p2).astype(v.dtype), v)

    o = lax.map(one, (blocks(q1), blocks(q2)))
    return o.transpose(1, 2, 0, 3, 4).reshape(b, h, tq, v.shape[-1])


def da_output(o, subln_g, lam_init):
    return from_heads(rms_norm(o, subln_g) * (1.0 - lam_init))


def gla_inputs(gq, gk, gv, ga, a2, ab):
    q = to_heads(gq, GLA_HEADS) * (GLA_DK ** -0.5)
    k = to_heads(gk, GLA_HEADS)
    v = to_heads(gv, GLA_HEADS)
    log_a = []
    for i in range(2):
        z = ga[..., i * GLA_RANK:(i + 1) * GLA_RANK] @ a2[i] + ab[i]
        log_a.append(to_heads(jax.nn.log_sigmoid(z.astype(jnp.float32)) / GLA_TAU, GLA_HEADS))
    return q, k, v, log_a[0], log_a[1]


def gla_chunked(q, k, v, log_a, s0):
    b, h, t, dk = q.shape
    dv = v.shape[-1]
    c = GLA_CHUNK
    n = t // c
    f32 = jnp.float32
    q = q.astype(f32).reshape(b, h, n, c, dk)
    k = k.astype(f32).reshape(b, h, n, c, dk)
    v = v.astype(f32).reshape(b, h, n, c, dv)
    cum = jnp.cumsum(log_a.reshape(b, h, n, c, dk), axis=3)
    cum_last = cum[:, :, :, -1:, :]
    qe = q * jnp.exp(cum)
    ke = k * jnp.exp(-cum)
    kd = k * jnp.exp(cum_last - cum)
    mask = jnp.tril(jnp.ones((c, c), dtype=bool))
    a_intra = jnp.where(mask, jnp.einsum('bhncd,bhnsd->bhncs', qe, ke), 0.0)
    o_intra = jnp.einsum('bhncs,bhnsv->bhncv', a_intra, v)
    d_state = jnp.einsum('bhncd,bhncv->nbhdv', kd, v)
    decay = jnp.exp(cum_last[:, :, :, 0, :]).transpose(2, 0, 1, 3)

    def step(s, inp):
        dec, ds = inp
        return dec[..., None] * s + ds, s

    s_final, s_prev = lax.scan(step, s0, (decay, d_state))
    o_inter = jnp.einsum('bhncd,nbhdv->bhncv', qe, s_prev)
    return (o_intra + o_inter).reshape(b, h, t, dv), s_final


def gla_bidirectional(lat, ctx):
    ql, kl, vl, lfl, lbl = lat
    qc, kc, vc, lfc, lbc = ctx
    b, h, _, dk = ql.shape
    s0 = jnp.zeros((b, h, dk, GLA_DV), jnp.float32)
    flip = lambda t: jnp.flip(t, axis=2)
    oc_f, sc_f = gla_chunked(qc, kc, vc, lfc, s0)
    oc_b, sc_b = gla_chunked(flip(qc), flip(kc), flip(vc), flip(lbc), s0)
    ol_f, _ = gla_chunked(ql, kl, vl, lfl, sc_f)
    ol_b, _ = gla_chunked(flip(ql), flip(kl), flip(vl), flip(lbl), sc_b)
    return ol_f + flip(ol_b), oc_f + flip(oc_b)


def gla_output(o, gg, gn_g):
    return from_heads(rms_norm(o, gn_g)).astype(gg.dtype) * jax.nn.silu(gg)


def na_heads(nq, nk, nv, qn_g, kn_g):
    q = rms_norm(to_heads(nq, NA_HEADS), qn_g) * (NA_DIM ** -0.5)
    k = rms_norm(to_heads(nk, NA_HEADS), kn_g)
    return q, k, to_heads(nv, NA_HEADS)


def neighborhood_attention(q, k, v, kc, vc, rpb):
    b, h, t, d = q.shape
    rows = t // GRID_W
    kr = min(NA_KR, rows)
    qg = q.reshape(b, h, rows, GRID_W, d)
    kg = k.reshape(b, h, rows, GRID_W, d)
    vg = v.reshape(b, h, rows, GRID_W, d)
    r_idx = jnp.arange(rows)
    row_start = jnp.clip(r_idx - kr // 2, 0, rows - kr)
    c_idx = jnp.arange(GRID_W)
    col_start = jnp.clip(c_idx - NA_KC // 2, 0, GRID_W - NA_KC)
    col_win = col_start[:, None] + jnp.arange(NA_KC)
    rel_col = col_win - c_idx[:, None] + (NA_KC - 1)
    rpb = rpb.astype(jnp.float32)
    n_loc = kr * NA_KC

    def row_fn(args):
        q_row, r, rs = args
        k_band = lax.dynamic_slice_in_dim(kg, rs, kr, axis=2)
        v_band = lax.dynamic_slice_in_dim(vg, rs, kr, axis=2)
        k_win = k_band[:, :, :, col_win, :]
        v_win = v_band[:, :, :, col_win, :]
        s_loc = jnp.einsum('bhwd,bhjwmd->bhwjm', q_row, k_win).astype(jnp.float32)
        rel_row = rs + jnp.arange(kr) - r + (NA_KR - 1)
        bias = rpb[:, rel_row[:, None, None], rel_col[None, :, :]]
        s_loc = s_loc + bias.transpose(0, 2, 1, 3)[None]
        s_ctx = jnp.einsum('bhwd,bhkd->bhwk', q_row, kc).astype(jnp.float32)
        s = jnp.concatenate([s_loc.reshape(b, h, GRID_W, n_loc), s_ctx], axis=-1)
        p = jax.nn.softmax(s, axis=-1).astype(v.dtype)
        p_loc = p[..., :n_loc].reshape(b, h, GRID_W, kr, NA_KC)
        return (jnp.einsum('bhwjm,bhjwmd->bhwd', p_loc, v_win)
                + jnp.einsum('bhwk,bhkd->bhwd', p[..., n_loc:], vc))

    o = lax.map(row_fn, (qg.transpose(2, 0, 1, 3, 4), r_idx, row_start))
    return o.transpose(1, 2, 0, 3, 4).reshape(b, h, t, d)


def branch_merge(y_da, y_gla, y_na, g_da, g_gla, g_na, w_br_da, w_br_gla, w_br_na, w_out):
    m = (jax.nn.sigmoid(g_da) * (y_da @ w_br_da)
         + jax.nn.sigmoid(g_gla) * (y_gla @ w_br_gla)
         + jax.nn.sigmoid(g_na) * (y_na @ w_br_na))
    return m @ w_out


def hybrid_mixer(h_lat, h_ctx, ang_row, ang_col, lam_init, need_ctx, w_in, da_qn_g, da_kn_g, da_lambda,
                 da_subln_g, gla_a2, gla_a_b, gla_gn_g, na_qn_g, na_kn_g, na_rpb, w_br_da, w_br_gla, w_br_na, w_out):
    zl = split_cols(h_lat @ w_in)
    zc = split_cols(h_ctx @ w_in)
    q1l, q2l, k1l, k2l, vl = da_heads(zl[0], zl[1], zl[2], da_qn_g, da_kn_g)
    q1l, q2l, k1l, k2l = [axial_rope(t, ang_row, ang_col) for t in (q1l, q2l, k1l, k2l)]
    q1c, q2c, k1c, k2c, vc = da_heads(zc[0], zc[1], zc[2], da_qn_g, da_kn_g)
    lp = da_lambda.astype(jnp.float32)
    lam = jnp.exp(jnp.sum(lp[0] * lp[1])) - jnp.exp(jnp.sum(lp[2] * lp[3])) + lam_init
    k1_all = jnp.concatenate([k1l, k1c], axis=2)
    k2_all = jnp.concatenate([k2l, k2c], axis=2)
    v_all = jnp.concatenate([vl, vc], axis=2)
    y_da_l = da_output(diff_attention(q1l, q2l, k1_all, k2_all, v_all, lam, Q_BLOCK), da_subln_g, lam_init)
    gl = gla_inputs(zl[3], zl[4], zl[5], zl[7], gla_a2, gla_a_b)
    gc = gla_inputs(zc[3], zc[4], zc[5], zc[7], gla_a2, gla_a_b)
    o_gla_l, o_gla_c = gla_bidirectional(gl, gc)
    y_gla_l = gla_output(o_gla_l, zl[6], gla_gn_g)
    nql, nkl, nvl = na_heads(zl[8], zl[9], zl[10], na_qn_g, na_kn_g)
    nqc, nkc, nvc = na_heads(zc[8], zc[9], zc[10], na_qn_g, na_kn_g)
    y_na_l = from_heads(neighborhood_attention(nql, nkl, nvl, nkc, nvc, na_rpb))
    out_l = branch_merge(y_da_l, y_gla_l, y_na_l, zl[11], zl[12], zl[13], w_br_da, w_br_gla, w_br_na, w_out)
    if not need_ctx:
        return out_l, None
    y_da_c = da_output(diff_attention(q1c, q2c, k1c, k2c, vc, lam, q1c.shape[2]), da_subln_g, lam_init)
    y_gla_c = gla_output(o_gla_c, zc[6], gla_gn_g)
    y_na_c = from_heads(softmax_attend(nqc, nkc, nvc))
    out_c = branch_merge(y_da_c, y_gla_c, y_na_c, zc[11], zc[12], zc[13], w_br_da, w_br_gla, w_br_na, w_out)
    return out_l, out_c


def sqrelu_mlp(h, w1, w2):
    a = jax.nn.relu(h @ w1)
    return (a * a) @ w2


def setup_inputs(seed: int = 0) -> dict:
    key = jax.random.key(seed)
    ks = jax.random.split(key, 32)
    f32 = jnp.float32
    nrm = lambda k, shape, s: jax.random.normal(k, shape, f32) * s
    d = D_MODEL
    return {
        'x': nrm(ks[0], (BATCH, SEQ, d), 1.0),
        'c': nrm(ks[1], (BATCH, d), 1.0),
        'ctx': nrm(ks[2], (BATCH, CTX_LEN, d), 1.0),
        'c_ctx': nrm(ks[3], (d,), 1.0),
        'w_mod': nrm(ks[4], (DEPTH, d, 6 * d), 0.5 * d ** -0.5),
        'b_mod': nrm(ks[5], (DEPTH, 6 * d), 0.02),
        'norm1_g': 1.0 + nrm(ks[6], (DEPTH, d), 0.02),
        'norm2_g': 1.0 + nrm(ks[7], (DEPTH, d), 0.02),
        'w_in': nrm(ks[8], (DEPTH, d, N_IN), d ** -0.5),
        'da_qn_g': 1.0 + nrm(ks[9], (DEPTH, HEAD_DIM), 0.02),
        'da_kn_g': 1.0 + nrm(ks[10], (DEPTH, HEAD_DIM), 0.02),
        'da_lambda': nrm(ks[11], (DEPTH, 4, HEAD_DIM), 0.1),
        'da_subln_g': 1.0 + nrm(ks[12], (DEPTH, DA_V), 0.02),
        'gla_a2': nrm(ks[13], (DEPTH, 2, GLA_RANK, GLA_HEADS * GLA_DK), GLA_RANK ** -0.5),
        'gla_a_b': nrm(ks[14], (DEPTH, 2, GLA_HEADS * GLA_DK), 0.1),
        'gla_gn_g': 1.0 + nrm(ks[15], (DEPTH, GLA_DV), 0.02),
        'na_qn_g': 1.0 + nrm(ks[16], (DEPTH, NA_DIM), 0.02),
        'na_kn_g': 1.0 + nrm(ks[17], (DEPTH, NA_DIM), 0.02),
        'na_rpb': nrm(ks[18], (DEPTH, NA_HEADS, 2 * NA_KR - 1, 2 * NA_KC - 1), 0.02),
        'w_br_da': nrm(ks[19], (DEPTH, BR_W, d), BR_W ** -0.5),
        'w_br_gla': nrm(ks[20], (DEPTH, BR_W, d), BR_W ** -0.5),
        'w_br_na': nrm(ks[21], (DEPTH, BR_W, d), BR_W ** -0.5),
        'w_out': nrm(ks[22], (DEPTH, d, d), d ** -0.5),
        'w_ff1': nrm(ks[23], (DEPTH, d, D_FF), d ** -0.5),
        'w_ff2': nrm(ks[24], (DEPTH, D_FF, d), D_FF ** -0.5),
    }


def reference(x, c, ctx, c_ctx, w_mod, b_mod, norm1_g, norm2_g, w_in, da_qn_g, da_kn_g, da_lambda, da_subln_g,
              gla_a2, gla_a_b, gla_gn_g, na_qn_g, na_kn_g, na_rpb, w_br_da, w_br_gla, w_br_na, w_out, w_ff1, w_ff2):
    t_len = x.shape[1]
    pos = jnp.arange(t_len)
    row = (pos // GRID_W).astype(jnp.float32)
    col = (pos % GRID_W).astype(jnp.float32)
    freqs = ROPE_BASE ** (-jnp.arange(ROPE_PAIRS, dtype=jnp.float32) / ROPE_PAIRS)
    ang_row = row[:, None] * freqs
    ang_col = col[:, None] * freqs
    for l in range(DEPTH):
        need_ctx = l < DEPTH - 1
        lam_init = 0.8 - 0.6 * math.exp(-0.3 * l)
        mod = jax.nn.silu(c) @ w_mod[l] + b_mod[l]
        mod_c = jax.nn.silu(c_ctx) @ w_mod[l] + b_mod[l]
        sh1, sc1, g1, sh2, sc2, g2 = [m[:, None, :] for m in jnp.split(mod, 6, axis=-1)]
        sh1c, sc1c, g1c, sh2c, sc2c, g2c = jnp.split(mod_c, 6, axis=-1)
        h_lat = rms_norm(x, norm1_g[l]) * (1.0 + sc1) + sh1
        h_ctx = rms_norm(ctx, norm1_g[l]) * (1.0 + sc1c) + sh1c
        m_lat, m_ctx = hybrid_mixer(h_lat, h_ctx, ang_row, ang_col, lam_init, need_ctx, w_in[l], da_qn_g[l],
                                    da_kn_g[l], da_lambda[l], da_subln_g[l], gla_a2[l], gla_a_b[l], gla_gn_g[l],
                                    na_qn_g[l], na_kn_g[l], na_rpb[l], w_br_da[l], w_br_gla[l], w_br_na[l], w_out[l])
        x = x + g1 * m_lat
        x = x + g2 * sqrelu_mlp(rms_norm(x, norm2_g[l]) * (1.0 + sc2) + sh2, w_ff1[l], w_ff2[l])
        if need_ctx:
            ctx = ctx + g1c * m_ctx
            ctx = ctx + g2c * sqrelu_mlp(rms_norm(ctx, norm2_g[l]) * (1.0 + sc2c) + sh2c, w_ff1[l], w_ff2[l])
    return x
```

```cpp
#include <hip/hip_runtime.h>
#include <hip/hip_cooperative_groups.h>
#include <cstdio>
#include <cstdint>
namespace cg = cooperative_groups;
__device__ __forceinline__ int opaque_zero() { int z; asm volatile("v_mov_b32 %0, 0" : "=v"(z)); return z; }
namespace pg8 {
#define PG8_LAS __attribute__((address_space(3)))
typedef unsigned short bf16_t;
typedef short bf16x8 __attribute__((ext_vector_type(8)));
typedef float f32x4 __attribute__((ext_vector_type(4)));
typedef unsigned u32x4 __attribute__((ext_vector_type(4)));
constexpr int BM = 256, BK = 64, HALF = 128, HTB = HALF * BK * 2  , STAGE_BYTES = 8 * HTB, NXCD = 8, WGM = 8;

__host__ __device__ __forceinline__ int lds_byte(int r, int c) { const int st = (r >> 4) * 2 + (c >> 5), rr = r & 15, cc = c & 31, ob = rr * 64 + cc * 2; return st * 1024 + (ob ^ (((ob >> 9) & 1) << 5)); }
__host__ __device__ __forceinline__ void stage_rc(int b, int& R, int& C) { const int st = b / 1024, sb = b % 1024, swz = sb ^ (((sb >> 9) & 1) << 5); R = (st >> 1) * 16 + swz / 64; C = (st & 1) * 32 + (swz % 64) / 2; }
__host__ __device__ __forceinline__ int perm32(int rho) { const int n = rho >> 4, i = rho & 15; return 8 * (i >> 2) + 4 * n + (i & 3); }

struct Unit { int pm, pn; };
struct Gemm { const bf16_t* A; const bf16_t* Bt; int M, N, K; };

struct StaticOrder {
    int nM, nN, nwg, G, c, fpm, fpn;
    __host__ __device__ void init(int M, int N, int G_, int c_) { nM = M / BM; nN = N / BM; nwg = nM * nN; G = G_; c = c_; fpm = -1; fpn = 0; }
    __host__ __device__ void init_one(int pm, int pn) { nM = 1; nN = 1; nwg = 1; G = 1; c = 0; fpm = pm; fpn = pn; }
    __host__ __device__ bool next(int i, Unit& u) const {
        if (fpm != -1) { if (i != 0 || fpm < 0) return false; u.pm = fpm; u.pn = fpn; return true; }
        const long L = (long)i * G + c; if (L >= nwg) return false;
        int wgid = (int)L; { const int q = nwg / NXCD, r = nwg % NXCD, xcd = wgid % NXCD, off = wgid / NXCD; wgid = (xcd < r ? xcd * (q + 1) : r * (q + 1) + (xcd - r) * q) + off; }
        const int nig = WGM * nN, gid = wgid / nig, fm = gid * WGM, gsz = (nM - fm) < WGM ? (nM - fm) : WGM;
        u.pm = fm + ((wgid % nig) % gsz); u.pn = (wgid % nig) / gsz; return true;
    }
    __device__ __forceinline__ void a_ready(const Unit&) const {}
    __device__ __forceinline__ void done(const Unit&) const {}
};

__device__ __forceinline__ unsigned cvt_pk_bf16(float lo, float hi) { unsigned r; asm volatile("v_cvt_pk_bf16_f32 %0, %1, %2" : "=v"(r) : "v"(lo), "v"(hi)); return r; }
template <class Epi, class Sched, bool ALIGN_EPI = false, bool SP2 = false>
__device__ __forceinline__ void gemm_phase(PG8_LAS unsigned char* lds, const Gemm g, const Sched& S, const Epi& E) {
    const int tid = (int)threadIdx.x + opaque_zero(), wid = __builtin_amdgcn_readfirstlane(tid >> 6), lane = tid & 63, wr = wid >> 2, wc = wid & 3, fr = lane & 15, fq = lane >> 4;
    const int K = g.K, nt = K / BK;
    unsigned voffA[2], voffB[2];
#pragma unroll
    for (int i = 0; i < 2; ++i) { int R, C; stage_rc(tid * 16 + i * 8192, R, C); const int Rb = Epi::PERM ? ((R & ~31) + perm32(R & 31)) : R;
        voffA[i] = (unsigned)(R * K + C) * 2u; voffB[i] = (unsigned)(Rb * K + C) * 2u; }
    const size_t kstep = (size_t)(BK * 2);
    const size_t hstep = (size_t)HALF * K * 2;
    const size_t tstep = 2 * hstep;
    const unsigned ldsw = (unsigned)wid * 1024u;
    const int aoff = lds_byte(wr * 64 + fr, fq * 8), boff = lds_byte(wc * 32 + fr, fq * 8);
#define PG8_SA(b, h) (((b) * 2 + (h)) * HTB)
#define PG8_SB(b, h) ((4 + (b) * 2 + (h)) * HTB)
#define PG8_STAGE(bufoff, gbase, voff) do { _Pragma("unroll") for (int _i = 0; _i < 2; ++_i) \
        __builtin_amdgcn_global_load_lds((const unsigned*)((const char*)(gbase) + (voff)[_i]), (PG8_LAS unsigned*)(lds + (bufoff) + ldsw + _i * 8192), 16, 0, 0); } while (0)
#define PG8_LDA(dst, b, h) do { _Pragma("unroll") for (int m = 0; m < 4; ++m) _Pragma("unroll") for (int k = 0; k < 2; ++k) dst[m][k] = *(const PG8_LAS bf16x8*)(lds + PG8_SA(b, h) + aoff + m * 2048 + k * 1024); } while (0)
#define PG8_LDB(dst, b, h) do { _Pragma("unroll") for (int n = 0; n < 2; ++n) _Pragma("unroll") for (int k = 0; k < 2; ++k) dst[n][k] = *(const PG8_LAS bf16x8*)(lds + PG8_SB(b, h) + boff + n * 2048 + k * 1024); } while (0)
#define PG8_MMA(ai, bj, At, Bt) do { __builtin_amdgcn_s_setprio(1); _Pragma("unroll") for (int m = 0; m < 4; ++m) _Pragma("unroll") for (int n = 0; n < 2; ++n) _Pragma("unroll") for (int k = 0; k < 2; ++k) \
        acc[ai][bj][m][n] = __builtin_amdgcn_mfma_f32_16x16x32_bf16(Bt[n][k], At[m][k], acc[ai][bj][m][n], 0, 0, 0); __builtin_amdgcn_s_setprio(0); } while (0)
#define PG8_WAIT_V(n) asm volatile("s_waitcnt vmcnt(" #n ")" ::: "memory")
#define PG8_WAIT_L(n) asm volatile("s_waitcnt lgkmcnt(" #n ")" ::: "memory")
#define PG8_BAR __builtin_amdgcn_s_barrier()
#define PG8_SCHED __builtin_amdgcn_sched_barrier(0)
    Unit cur, nxt; int ui = 0;
    if (!S.next(0, cur)) return;
    f32x4 acc[2][2][4][2];
#pragma unroll
    for (int a = 0; a < 2; ++a)
#pragma unroll
        for (int b = 0; b < 2; ++b)
#pragma unroll
            for (int m = 0; m < 4; ++m)
#pragma unroll
                for (int n = 0; n < 2; ++n) acc[a][b][m][n] = (f32x4){0.f, 0.f, 0.f, 0.f};
    bf16x8 At[4][2], B0[2][2], B1[2][2];
    const char* cA = (const char*)g.A + (size_t)cur.pm * tstep; const char* cB = (const char*)g.Bt + (size_t)cur.pn * tstep;
    S.a_ready(cur);
    if constexpr (SP2) {
        PG8_STAGE(PG8_SB(0, 0), cB, voffB); PG8_STAGE(PG8_SB(0, 1), cB + hstep, voffB); PG8_STAGE(PG8_SA(0, 0), cA, voffA); PG8_STAGE(PG8_SA(0, 1), cA + hstep, voffA);
        if (wr == 1) PG8_BAR;
        PG8_WAIT_V(2); PG8_BAR;
        PG8_STAGE(PG8_SB(1, 0), cB + kstep, voffB); PG8_STAGE(PG8_SA(1, 0), cA + kstep, voffA); PG8_STAGE(PG8_SB(1, 1), cB + hstep + kstep, voffB);
        PG8_WAIT_V(6); PG8_BAR;
    } else {
        PG8_STAGE(PG8_SB(0, 0), cB, voffB); PG8_STAGE(PG8_SA(0, 0), cA, voffA); PG8_STAGE(PG8_SB(0, 1), cB + hstep, voffB); PG8_STAGE(PG8_SA(0, 1), cA + hstep, voffA);
        if (wr == 1) PG8_BAR;
        PG8_WAIT_V(4); PG8_BAR;
        PG8_STAGE(PG8_SB(1, 0), cB + kstep, voffB); PG8_STAGE(PG8_SA(1, 0), cA + kstep, voffA); PG8_STAGE(PG8_SB(1, 1), cB + hstep + kstep, voffB);
        PG8_WAIT_V(6); PG8_BAR;
    }
    for (;;) {
        const bool has_next = S.next(ui + 1, nxt);
        const char* nA = has_next ? (const char*)g.A + (size_t)nxt.pm * tstep : cA; const char* nB = has_next ? (const char*)g.Bt + (size_t)nxt.pn * tstep : cB;
        for (int t = 0; t < nt; t += 2) {
            const bool last = (t == nt - 2);
            const char* a1 = cA + (size_t)(t + 1) * kstep;
            const char* a2 = last ? nA : cA + (size_t)(t + 2) * kstep; const char* b2 = last ? nB : cB + (size_t)(t + 2) * kstep;
            const char* a3 = a2 + kstep; const char* b3 = b2 + kstep;
            if (last && has_next) S.a_ready(nxt);
            if constexpr (SP2) {
            PG8_LDB(B0, 0, 0); PG8_LDB(B1, 0, 1); PG8_SCHED; PG8_LDA(At, 0, 0); PG8_STAGE(PG8_SA(1, 1), a1 + hstep, voffA);
            PG8_WAIT_V(8); PG8_WAIT_L(0); PG8_BAR; PG8_MMA(0, 0, At, B0); PG8_MMA(0, 1, At, B1); PG8_BAR; PG8_SCHED;
            PG8_LDA(At, 0, 1); PG8_STAGE(PG8_SB(0, 0), b2, voffB); PG8_STAGE(PG8_SB(0, 1), b2 + hstep, voffB); PG8_STAGE(PG8_SA(0, 0), a2, voffA);
            PG8_WAIT_V(8); PG8_WAIT_L(0); PG8_BAR; PG8_MMA(1, 0, At, B0); PG8_MMA(1, 1, At, B1); PG8_BAR; PG8_SCHED;
            PG8_LDB(B0, 1, 0); PG8_LDB(B1, 1, 1); PG8_SCHED; PG8_LDA(At, 1, 0); PG8_STAGE(PG8_SA(0, 1), a2 + hstep, voffA);
            PG8_WAIT_V(8); PG8_WAIT_L(0); PG8_BAR; PG8_MMA(0, 0, At, B0); PG8_MMA(0, 1, At, B1); PG8_BAR; PG8_SCHED;
            PG8_LDA(At, 1, 1); PG8_STAGE(PG8_SB(1, 0), b3, voffB); PG8_STAGE(PG8_SB(1, 1), b3 + hstep, voffB); PG8_STAGE(PG8_SA(1, 0), a3, voffA);
            PG8_WAIT_V(8); PG8_WAIT_L(0); PG8_BAR; PG8_MMA(1, 0, At, B0); PG8_MMA(1, 1, At, B1); PG8_BAR; PG8_SCHED;
            } else {
            PG8_LDB(B0, 0, 0); PG8_SCHED; PG8_LDA(At, 0, 0); PG8_STAGE(PG8_SA(1, 1), a1 + hstep, voffA);
            PG8_WAIT_L(8); PG8_BAR; PG8_WAIT_L(0); PG8_MMA(0, 0, At, B0); PG8_BAR; PG8_SCHED;
            PG8_LDB(B1, 0, 1); PG8_STAGE(PG8_SB(0, 0), b2, voffB);
            PG8_BAR; PG8_WAIT_L(0); PG8_MMA(0, 1, At, B1); PG8_BAR;
            PG8_LDA(At, 0, 1); PG8_STAGE(PG8_SA(0, 0), a2, voffA);
            PG8_BAR; PG8_WAIT_L(0); PG8_MMA(1, 0, At, B0); PG8_BAR; PG8_SCHED;
            PG8_STAGE(PG8_SB(0, 1), b2 + hstep, voffB);
            PG8_WAIT_V(6); PG8_BAR; PG8_MMA(1, 1, At, B1); PG8_BAR;
            PG8_LDB(B0, 1, 0); PG8_SCHED; PG8_LDA(At, 1, 0); PG8_STAGE(PG8_SA(0, 1), a2 + hstep, voffA);
            PG8_WAIT_L(8); PG8_BAR; PG8_WAIT_L(0); PG8_MMA(0, 0, At, B0); PG8_BAR; PG8_SCHED;
            PG8_LDB(B1, 1, 1); PG8_STAGE(PG8_SB(1, 0), b3, voffB);
            PG8_BAR; PG8_WAIT_L(0); PG8_MMA(0, 1, At, B1); PG8_BAR;
            PG8_LDA(At, 1, 1); PG8_STAGE(PG8_SA(1, 0), a3, voffA);
            PG8_BAR; PG8_WAIT_L(0); PG8_MMA(1, 0, At, B0); PG8_BAR; PG8_SCHED;
            PG8_STAGE(PG8_SB(1, 1), b3 + hstep, voffB);
            PG8_WAIT_V(6); PG8_BAR; PG8_MMA(1, 1, At, B1); PG8_BAR;
            }
        }
        if constexpr (ALIGN_EPI) { if (wr == 0) PG8_BAR; }
        if constexpr (!Epi::AFTER_DRAIN) { E(acc, cur, wr, wc, fr, fq); S.done(cur); }
        if (!has_next) break;
#pragma unroll
        for (int a = 0; a < 2; ++a)
#pragma unroll
            for (int b = 0; b < 2; ++b)
#pragma unroll
                for (int m = 0; m < 4; ++m)
#pragma unroll
                    for (int n = 0; n < 2; ++n) acc[a][b][m][n] = (f32x4){0.f, 0.f, 0.f, 0.f};
        cur = nxt; cA = nA; cB = nB; ++ui;
        if constexpr (ALIGN_EPI) { if (wr == 1) PG8_BAR; }
    }
    PG8_WAIT_V(0);
    if constexpr (!ALIGN_EPI) { if (wr == 0) PG8_BAR; }
    PG8_BAR;
    if constexpr (Epi::AFTER_DRAIN) { E.fused(acc, cur, wr, wc, fr, fq, lds, wid, lane); S.done(cur); }
#undef PG8_SA
#undef PG8_SB
#undef PG8_STAGE
#undef PG8_LDA
#undef PG8_LDB
#undef PG8_MMA
#undef PG8_WAIT_V
#undef PG8_WAIT_L
#undef PG8_BAR
#undef PG8_SCHED
}
}
using pg8::bf16_t; using pg8::bf16x8; using pg8::f32x4; using pg8::u32x4; using pg8::Unit;
typedef float f32x16 __attribute__((ext_vector_type(16)));
typedef float f32x2 __attribute__((ext_vector_type(2)));
typedef unsigned u32x2 __attribute__((ext_vector_type(2)));
typedef __bf16 bf16x2v __attribute__((ext_vector_type(2)));
#define DI __device__ __forceinline__
#define LAS __attribute__((address_space(3)))
#define LDS_WAIT() asm volatile("s_waitcnt lgkmcnt(0)" ::: "memory")
#define MFMA32(a, b, c) __builtin_amdgcn_mfma_f32_32x32x16_bf16((a), (b), (c), 0, 0, 0)

#define XB_TMO      128
#define XB_XCNT(j)  (256  + 64 * (j))
#define XB_XSUB(j)  (1280 + 64 * (j))
#define XB_XGEN(j)  (2304 + 64 * (j))
#define XB_TOP      3328
#define XB_TOPGEN   3392
#define XCD_BAR_WORDS 3456
#define XB_SPIN_CAP (1u << 18)

__device__ __forceinline__ unsigned xb_ld(unsigned* p)              { return __hip_atomic_load(p, __ATOMIC_RELAXED, __HIP_MEMORY_SCOPE_AGENT); }
__device__ __forceinline__ unsigned xb_add(unsigned* p, unsigned v) { return __hip_atomic_fetch_add(p, v, __ATOMIC_RELAXED, __HIP_MEMORY_SCOPE_AGENT); }
__device__ __forceinline__ unsigned xb_xcc_id() { return (unsigned)__builtin_amdgcn_s_getreg((3 << 11) | 20) & 0xFu; }
#define XB_SPIN(cond, bar) do { unsigned _sp = 0; while (cond) { __builtin_amdgcn_s_sleep(1); \
    if ((++_sp & 255u) == 0u) { if (xb_ld(&(bar)[XB_TMO])) break; if (_sp > XB_SPIN_CAP) { atomicAdd(&(bar)[XB_TMO], 1u); break; } } } } while (0)

struct XcdBarrier {
    unsigned* bar; unsigned x;
    volatile LAS unsigned* st;
};

__device__ __forceinline__ XcdBarrier xcd_barrier_post(unsigned* bar, volatile LAS unsigned* st) {
    XcdBarrier b; b.bar = bar; b.x = xb_xcc_id(); b.st = st;
    if (threadIdx.x == 0) (void)xb_add(&bar[XB_XCNT(b.x)], 1u);
    return b;
}
__device__ __forceinline__ void xcd_barrier_complete(unsigned* bar, unsigned x, unsigned& nloc, unsigned& nx) {
    const unsigned G = gridDim.x * gridDim.y * gridDim.z;
    unsigned sum, cnt, mine, sp = 0u;
    for (;;) {
        sum = 0u; cnt = 0u; mine = 0u;
#pragma unroll
        for (unsigned j = 0; j < 16; ++j) { const unsigned c = xb_ld(&bar[XB_XCNT(j)]); sum += c; cnt += (c > 0u) ? 1u : 0u; mine = (j == x) ? c : mine; }
        if (sum == G) break;
        __builtin_amdgcn_s_sleep(1);
        if ((++sp & 255u) == 0u) { if (xb_ld(&bar[XB_TMO])) break; if (sp > XB_SPIN_CAP) { atomicAdd(&bar[XB_TMO], 1u); break; } }
    }
    nloc = mine > 0u ? mine : 1u; nx = cnt > 0u ? cnt : 1u;
}

__device__ __forceinline__ void xcd_barrier(const XcdBarrier& b) {
    asm volatile("s_waitcnt vmcnt(0)" ::: "memory");
    __syncthreads();
    if (threadIdx.x == 0) {
        unsigned* bar = b.bar;
        __builtin_amdgcn_s_waitcnt(0);
        unsigned nloc = b.st[0], nx = b.st[1];
        if (nloc == 0u) { xcd_barrier_complete(bar, b.x, nloc, nx); b.st[0] = nloc; b.st[1] = nx; }
        const unsigned old = xb_add(&bar[XB_XSUB(b.x)], 1u);
        const unsigned gen = old / nloc;
        if (old + 1u == (gen + 1u) * nloc) {
            __builtin_amdgcn_fence(__ATOMIC_RELEASE, "agent");
            asm volatile("s_waitcnt vmcnt(0)" ::: "memory");
            const unsigned og = xb_add(&bar[XB_TOP], 1u);
            const unsigned tg = og / nx;
            if (og + 1u == (tg + 1u) * nx) xb_add(&bar[XB_TOPGEN], 1u);
            else XB_SPIN(xb_ld(&bar[XB_TOPGEN]) == tg, bar);
            __builtin_amdgcn_fence(__ATOMIC_ACQUIRE, "agent");
            xb_add(&bar[XB_XGEN(b.x)], 1u);
            asm volatile("s_waitcnt vmcnt(0)" ::: "memory");
        } else {
            XB_SPIN(xb_ld(&bar[XB_XGEN(b.x)]) == gen, bar);
            __builtin_amdgcn_fence(__ATOMIC_ACQUIRE, "agent");
            asm volatile("s_waitcnt vmcnt(0)" ::: "memory");
        }
    }
    __syncthreads();
}


constexpr int D = 1024, TL = 16384, CL = 256, RB = TL + CL, NZ = 7936, ZP = 7712, FF = 4096, NMOD = 6144;
constexpr float EPS = 1e-6f, LOG2E = 1.4426950408889634f;
constexpr int C_DQ = 0, C_DK = 512, C_DV = 1024, C_GQ = 1536, C_GK = 1792, C_GV = 2048, C_GG = 2560, C_NQ = 3072, C_NK = 3584, C_NV = 4096, C_GATE = 4608, C_GA = 7680;
constexpr size_t KiB = 1024, MiB = 1024 * 1024;
constexpr size_t WS_MOD = 0, WS_BIN = 256 * KiB, WS_BF1 = 512 * KiB, WS_DEC = 1 * MiB, WS_RSS = 2 * MiB, WS_XSC = 4 * MiB, WS_W = 6 * MiB;
constexpr size_t WL_ELEMS = 19136512, WL_BYTES = WL_ELEMS * 2;
constexpr size_t OFF_WIN = 0, OFF_BR = (size_t)NZ * D, OFF_OUT = OFF_BR + 3 * 524288, OFF_W1 = OFF_OUT + 1048576, OFF_W2 = OFF_W1 + 4194304;
static_assert(OFF_W2 + 4194304 == WL_ELEMS, "weights");
constexpr size_t WS_BAR = 3 * MiB + 512 * KiB;
constexpr size_t WS_A0 = 79 * MiB;
constexpr size_t WS_Y = WS_A0 + (size_t)RB * D * 2;
constexpr size_t YB = (size_t)RB * 512 * 2;
constexpr size_t WS_Z = 161 * MiB;
constexpr size_t WS_S = 406 * MiB;
constexpr size_t WS_VTD = 471 * MiB;
constexpr size_t WS_VTN = WS_VTD + (size_t)512 * RB * 2;
constexpr size_t WS_END = WS_VTN + (size_t)512 * RB * 2;
static_assert(WS_Y + 3 * YB <= WS_Z && WS_Z + (size_t)RB * ZP * 2 <= WS_S && WS_S + (size_t)8 * 260 * 8192 * 4 <= WS_VTD && WS_END <= 504 * MiB, "ws map");
static_assert(WS_W + 2 * WL_BYTES <= WS_A0 && WS_RSS + (size_t)RB * 16 * 4 <= WS_XSC, "ws map 2");

struct Params { const float* in[25]; float* out; unsigned char* ws; };

DI int lane_id_opq() { return (int)__builtin_amdgcn_mbcnt_hi(~0u, __builtin_amdgcn_mbcnt_lo(~0u, (unsigned)opaque_zero())); }
DI float shx(float v, int k) {
  const int x = __float_as_int(v);
  switch (k) {
    case 1: return __int_as_float(__builtin_amdgcn_ds_swizzle(x, 0x041F));
    case 2: return __int_as_float(__builtin_amdgcn_ds_swizzle(x, 0x081F));
    case 4: return __int_as_float(__builtin_amdgcn_ds_swizzle(x, 0x101F));
    case 8: return __int_as_float(__builtin_amdgcn_ds_swizzle(x, 0x201F));
    case 16: return __int_as_float(__builtin_amdgcn_ds_swizzle(x, 0x401F));
    default: return __int_as_float(__builtin_amdgcn_ds_bpermute((lane_id_opq() ^ k) << 2, x));
  }
}
DI float rdl63(float v) { return __int_as_float(__builtin_amdgcn_readlane(__float_as_int(v), 63)); }
DI float bf2f(unsigned short h) { return __uint_as_float(((unsigned)h) << 16); }
DI unsigned pk2(float lo, float hi) { f32x2 f = {lo, hi}; bf16x2v h = __builtin_convertvector(f, bf16x2v); return __builtin_bit_cast(unsigned, h); }
DI void unpack8(const u32x4 w, float (&v)[8]) {
#pragma unroll
  for (int i = 0; i < 4; ++i) { v[2 * i] = __uint_as_float(w[i] << 16); v[2 * i + 1] = __uint_as_float(w[i] & 0xffff0000u); }
}
DI u32x4 pack8(const float (&v)[8]) { u32x4 w; w.x = pk2(v[0], v[1]); w.y = pk2(v[2], v[3]); w.z = pk2(v[4], v[5]); w.w = pk2(v[6], v[7]); return w; }
DI float wave_sum(float v) {
#pragma unroll
  for (int o = 1; o < 64; o <<= 1) v += shx(v, o);
  return v;
}
DI f32x16 zero16() { f32x16 z;
#pragma unroll
  for (int i = 0; i < 16; ++i) z[i] = 0.f; return z; }
DI bf16x8 pack_frag(const f32x16& x, int s) {
  u32x4 p;
  if (s == 0) { p.x = pk2(x[0], x[1]); p.y = pk2(x[2], x[3]); p.z = pk2(x[4], x[5]); p.w = pk2(x[6], x[7]); }
  else { p.x = pk2(x[8], x[9]); p.y = pk2(x[10], x[11]); p.z = pk2(x[12], x[13]); p.w = pk2(x[14], x[15]); }
  return __builtin_bit_cast(bf16x8, p);
}
DI float sigm(float x) { return __builtin_amdgcn_rcpf(1.f + __builtin_amdgcn_exp2f(-LOG2E * x)); }
DI float row_rstd(const float* rss, int row) { const f32x4* p = (const f32x4*)(rss + (size_t)row * 16); const f32x4 a = (p[0] + p[1]) + (p[2] + p[3]); return rsqrtf(((a.x + a.y) + (a.z + a.w)) * (1.f / 1024.f) + EPS); }

struct EpiZ {
  static constexpr bool PERM = true, AFTER_DRAIN = false;
  bf16_t* Z; const float* rss; const float* bias; int b;
  DI void operator()(const f32x4 (&acc)[2][2][4][2], const Unit& u, int wr, int wc, int fr, int fq) const {
    const int row0 = u.pm * 256 + wr * 64 + fr, mi = (u.pm < 64) ? b : 2, col0 = u.pn * 256 + wc * 32 + 8 * fq;
    const bool gate = (u.pn >= 18) && (u.pn < 30);
    f32x4 bv[2][2];
#pragma unroll
    for (int bj = 0; bj < 2; ++bj)
#pragma unroll
      for (int n = 0; n < 2; ++n) bv[bj][n] = *(const f32x4*)(bias + (size_t)mi * NZ + col0 + bj * 128 + 4 * n);
#pragma unroll
    for (int ai = 0; ai < 2; ++ai)
#pragma unroll
      for (int m = 0; m < 4; ++m) {
        const int row = row0 + ai * 128 + m * 16; const float rs = row_rstd(rss, row); bf16_t* rowp = Z + (size_t)row * ZP + col0;
#pragma unroll
        for (int bj = 0; bj < 2; ++bj) {
          f32x4 v0 = acc[ai][bj][m][0] * rs + bv[bj][0], v1 = acc[ai][bj][m][1] * rs + bv[bj][1];
          if (gate) {
#pragma unroll
            for (int e = 0; e < 4; ++e) { v0[e] = sigm(v0[e]); v1[e] = sigm(v1[e]); }
          }
          u32x4 w; w.x = pk2(v0[0], v0[1]); w.y = pk2(v0[2], v0[3]); w.z = pk2(v1[0], v1[1]); w.w = pk2(v1[2], v1[3]);
          if (col0 + bj * 128 < ZP) *(u32x4*)(rowp + bj * 128) = w;
        }
      }
  }
};
struct EpiF1 {
  static constexpr bool PERM = true, AFTER_DRAIN = false;
  bf16_t* H; const float* rss; const float* bias; int b;
  DI void operator()(const f32x4 (&acc)[2][2][4][2], const Unit& u, int wr, int wc, int fr, int fq) const {
    const int row0 = u.pm * 256 + wr * 64 + fr, mi = (u.pm < 64) ? b : 2, col0 = u.pn * 256 + wc * 32 + 8 * fq;
    f32x4 bv[2][2];
#pragma unroll
    for (int bj = 0; bj < 2; ++bj)
#pragma unroll
      for (int n = 0; n < 2; ++n) bv[bj][n] = *(const f32x4*)(bias + (size_t)mi * FF + col0 + bj * 128 + 4 * n);
#pragma unroll
    for (int ai = 0; ai < 2; ++ai)
#pragma unroll
      for (int m = 0; m < 4; ++m) {
        const int row = row0 + ai * 128 + m * 16; const float rs = row_rstd(rss, row); bf16_t* rowp = H + (size_t)row * FF + col0;
#pragma unroll
        for (int bj = 0; bj < 2; ++bj) {
          f32x4 v0 = acc[ai][bj][m][0] * rs + bv[bj][0], v1 = acc[ai][bj][m][1] * rs + bv[bj][1];
#pragma unroll
          for (int e = 0; e < 4; ++e) { float a = fmaxf(v0[e], 0.f), c = fmaxf(v1[e], 0.f); v0[e] = a * a; v1[e] = c * c; }
          u32x4 w; w.x = pk2(v0[0], v0[1]); w.y = pk2(v0[2], v0[3]); w.z = pk2(v1[0], v1[1]); w.w = pk2(v1[2], v1[3]);
          *(u32x4*)(rowp + bj * 128) = w;
        }
      }
  }
};
struct EpiMerge {
  static constexpr bool PERM = true, AFTER_DRAIN = false;
  const bf16_t* Z; bf16_t* Mb; int step;
  DI void operator()(const f32x4 (&acc)[2][2][4][2], const Unit& u, int wr, int wc, int fr, int fq) const {
    const int row0 = u.pm * 256 + wr * 64 + fr, col0 = u.pn * 256 + wc * 32 + 8 * fq;
#pragma unroll
    for (int ai = 0; ai < 2; ++ai)
#pragma unroll
      for (int m = 0; m < 4; ++m) {
        const int row = row0 + ai * 128 + m * 16;
#pragma unroll
        for (int bj = 0; bj < 2; ++bj) {
          const int col = col0 + bj * 128;
          float g[8], v[8]; unpack8(*(const u32x4*)(Z + (size_t)row * ZP + C_GATE + step * 1024 + col), g);
#pragma unroll
          for (int e = 0; e < 4; ++e) { v[e] = g[e] * acc[ai][bj][m][0][e]; v[4 + e] = g[4 + e] * acc[ai][bj][m][1][e]; }
          if (step > 0) { float p[8]; unpack8(*(const u32x4*)(Mb + (size_t)row * D + col), p);
#pragma unroll
            for (int e = 0; e < 8; ++e) v[e] += p[e]; }
          *(u32x4*)(Mb + (size_t)row * D + col) = pack8(v);
        }
      }
  }
};
struct EpiRes {
  static constexpr bool PERM = true, AFTER_DRAIN = false;
  const float* inLat; const float* inCtx; float* outLat; float* outCtx; const float* gv; const float* ng; const float* scn; bf16_t* An; float* rss; int b;
  DI void operator()(const f32x4 (&acc)[2][2][4][2], const Unit& u, int wr, int wc, int fr, int fq) const {
    const int row0 = u.pm * 256 + wr * 64 + fr, mi = (u.pm < 64) ? b : 2, col0 = u.pn * 256 + wc * 32 + 8 * fq;
    const bool lat = u.pm < 64;
    float ssr[2][4];
#pragma unroll
    for (int ai = 0; ai < 2; ++ai)
#pragma unroll
      for (int m = 0; m < 4; ++m) ssr[ai][m] = 0.f;
#pragma unroll
    for (int bj = 0; bj < 2; ++bj) {
      const int col = col0 + bj * 128;
      const f32x4 g0 = *(const f32x4*)(gv + (size_t)mi * NMOD + col), g1 = *(const f32x4*)(gv + (size_t)mi * NMOD + col + 4);
      f32x4 w0 = {0.f, 0.f, 0.f, 0.f}, w1 = {0.f, 0.f, 0.f, 0.f};
      if (An) { w0 = *(const f32x4*)(ng + col) * (*(const f32x4*)(scn + (size_t)mi * NMOD + col) + 1.f); w1 = *(const f32x4*)(ng + col + 4) * (*(const f32x4*)(scn + (size_t)mi * NMOD + col + 4) + 1.f); }
#pragma unroll
      for (int ai = 0; ai < 2; ++ai)
#pragma unroll
        for (int m = 0; m < 4; ++m) {
          const int row = row0 + ai * 128 + m * 16;
          const float* ip = lat ? inLat + (size_t)row * D + col : inCtx + (size_t)(row - TL) * D + col;
          float* op = lat ? outLat + (size_t)row * D + col : outCtx + (size_t)(row - TL) * D + col;
          const f32x4 y0 = *(const f32x4*)ip + g0 * acc[ai][bj][m][0], y1 = *(const f32x4*)(ip + 4) + g1 * acc[ai][bj][m][1];
          *(f32x4*)op = y0; *(f32x4*)(op + 4) = y1;
          if (An) {
            ssr[ai][m] += (y0.x * y0.x + y0.y * y0.y) + (y0.z * y0.z + y0.w * y0.w) + (y1.x * y1.x + y1.y * y1.y) + (y1.z * y1.z + y1.w * y1.w);
            const f32x4 a0 = y0 * w0, a1 = y1 * w1; u32x4 w; w.x = pk2(a0.x, a0.y); w.y = pk2(a0.z, a0.w); w.z = pk2(a1.x, a1.y); w.w = pk2(a1.z, a1.w);
            *(u32x4*)(An + (size_t)row * D + col) = w;
          }
        }
    }
    if (An) {
#pragma unroll
      for (int ai = 0; ai < 2; ++ai)
#pragma unroll
        for (int m = 0; m < 4; ++m) { float s = ssr[ai][m]; s += shx(s, 16); s += shx(s, 32);
          if (fq == 0) rss[(size_t)(row0 + ai * 128 + m * 16) * 16 + u.pn * 4 + wc] = s; }
    }
  }
};
DI void phase_mod(const Params& P, LAS unsigned char* lds, int tid) {
  LAS float* sc = (LAS float*)lds; LAS float* red = sc + 3072;
  const float* c = P.in[1]; const float* cctx = P.in[3]; const float* wmod = P.in[4]; const float* bmod = P.in[5];
  float* mod = (float*)(P.ws + WS_MOD);
  for (int i = tid; i < 3072; i += 512) { const float v = (i < 2048) ? c[i] : cctx[i - 2048]; sc[i] = v / (1.f + __expf(-v)); }
  __syncthreads();
  for (int u = blockIdx.x; u < 192; u += gridDim.x) {
    const int l = u / 96, n0 = (u % 96) * 64, cl = tid & 63, ks = tid >> 6;
    const float* W = wmod + (size_t)l * D * NMOD + n0 + cl;
    float a0 = 0.f, a1 = 0.f, a2 = 0.f;
#pragma unroll 8
    for (int k = ks * 128; k < ks * 128 + 128; ++k) { const float w = W[(size_t)k * NMOD]; a0 += sc[k] * w; a1 += sc[1024 + k] * w; a2 += sc[2048 + k] * w; }
    red[tid * 3 + 0] = a0; red[tid * 3 + 1] = a1; red[tid * 3 + 2] = a2;
    __syncthreads();
    if (tid < 192) { const int mi = tid >> 6, c2 = tid & 63; float s = 0.f;
      for (int q = 0; q < 8; ++q) s += red[(q * 64 + c2) * 3 + mi];
      mod[(size_t)(l * 3 + mi) * NMOD + n0 + c2] = s + bmod[l * NMOD + n0 + c2]; }
    __syncthreads();
  }
}
DI void tr_item(const float* W, int K, int N, bf16_t* WT, int dst_row, int k0, int n0, LAS float* scr, int lane) {
#pragma unroll 16
  for (int i = 0; i < 32; ++i) { const int kk = 2 * i + (lane >> 5); scr[kk * 33 + (lane & 31)] = W[(size_t)(k0 + kk) * N + n0 + (lane & 31)]; }
  LDS_WAIT();
  const int c = lane & 7;
#pragma unroll
  for (int j = 0; j < 4; ++j) { const int n = (lane >> 3) + 8 * j; const LAS float* s = scr + (8 * c) * 33 + n;
    u32x4 o; o.x = pk2(s[0 * 33], s[1 * 33]); o.y = pk2(s[2 * 33], s[3 * 33]); o.z = pk2(s[4 * 33], s[5 * 33]); o.w = pk2(s[6 * 33], s[7 * 33]);
    *(u32x4*)(WT + (size_t)(dst_row + n) * K + k0 + 8 * c) = o; }
  LDS_WAIT();
}
DI void phase_convert(const Params& P, LAS unsigned char* lds, int tid) {
  const int lane = tid & 63, wave = tid >> 6, gw = blockIdx.x * 8 + wave, NGW = gridDim.x * 8;
  LAS float* scr = (LAS float*)(lds + 49152 + wave * 8448);
  constexpr int PER = 3856 + 768 + 512 + 2048 + 2048;
  for (int it = gw; it < 2 * PER; it += NGW) {
    const int l = it / PER; int r = it % PER;
    bf16_t* WL = (bf16_t*)(P.ws + WS_W + (size_t)l * WL_BYTES);
    if (r < 3856) { const int kb = r / 241, nb = r % 241, n0 = nb * 32, dst = nb < 96 ? n0 : (nb == 96 ? C_GA : n0 - 32);
      tr_item(P.in[8] + (size_t)l * D * 7712, D, 7712, WL + OFF_WIN, dst, kb * 64, n0, scr, lane); continue; }
    r -= 3856;
    if (r < 768) { const int br = r / 256, rr = r % 256, kb = rr / 32, nb = rr % 32;
      tr_item(P.in[19 + br] + (size_t)l * 512 * D, 512, D, WL + OFF_BR + (size_t)br * 524288, nb * 32, kb * 64, nb * 32, scr, lane); continue; }
    r -= 768;
    if (r < 512) { const int kb = r / 32, nb = r % 32; tr_item(P.in[22] + (size_t)l * D * D, D, D, WL + OFF_OUT, nb * 32, kb * 64, nb * 32, scr, lane); continue; }
    r -= 512;
    if (r < 2048) { const int kb = r / 128, nb = r % 128; tr_item(P.in[23] + (size_t)l * D * FF, D, FF, WL + OFF_W1, nb * 32, kb * 64, nb * 32, scr, lane); continue; }
    r -= 2048;
    { const int kb = r / 32, nb = r % 32; tr_item(P.in[24] + (size_t)l * FF * D, FF, D, WL + OFF_W2, nb * 32, kb * 64, nb * 32, scr, lane); }
  }
  for (int i = blockIdx.x * 512 + tid; i < 2 * 28672; i += gridDim.x * 512) { const int l = i / 28672, q = i % 28672;
    u32x4 z = {0u, 0u, 0u, 0u}; *(u32x4*)((bf16_t*)(P.ws + WS_W + (size_t)l * WL_BYTES) + OFF_WIN + (size_t)7712 * D + (size_t)q * 8) = z; }
}
DI void phase_bias(const Params& P, int tid) {
  const int lane = tid & 63, wave = tid >> 6, gw = blockIdx.x * 8 + wave, NGW = gridDim.x * 8;
  const float* mod = (const float*)(P.ws + WS_MOD);
  for (int it = gw; it < 2 * 11808; it += NGW) {
    const int l = it / 11808; int r = it % 11808;
    const bf16_t* WL = (const bf16_t*)(P.ws + WS_W + (size_t)l * WL_BYTES);
    const bf16_t* wrow; const float* shv; float* dst; int dstride;
    if (r < 7712) { wrow = WL + OFF_WIN + (size_t)r * D; shv = mod + (size_t)l * 3 * NMOD; dst = (float*)(P.ws + WS_BIN) + (size_t)l * 3 * NZ + r; dstride = NZ; }
    else { r -= 7712; wrow = WL + OFF_W1 + (size_t)r * D; shv = mod + (size_t)l * 3 * NMOD + 3072; dst = (float*)(P.ws + WS_BF1) + (size_t)l * 3 * FF + r; dstride = FF; }
    float w[16]; { float t[8]; unpack8(*(const u32x4*)(wrow + 16 * lane), t);
#pragma unroll
      for (int e = 0; e < 8; ++e) w[e] = t[e];
      unpack8(*(const u32x4*)(wrow + 16 * lane + 8), t);
#pragma unroll
      for (int e = 0; e < 8; ++e) w[8 + e] = t[e]; }
#pragma unroll
    for (int mi = 0; mi < 3; ++mi) { const float* sp = shv + (size_t)mi * NMOD + 16 * lane; float s = 0.f;
#pragma unroll
      for (int q = 0; q < 4; ++q) { const f32x4 x = *(const f32x4*)(sp + 4 * q); s += x.x * w[4 * q] + x.y * w[4 * q + 1] + x.z * w[4 * q + 2] + x.w * w[4 * q + 3]; }
      s = wave_sum(s); if (lane == 0) dst[(size_t)mi * dstride] = s; }
  }
}
DI void phase_prep(const Params& P, int b, int tid) {
  const int lane = tid & 63, wave = tid >> 6, gw = blockIdx.x * 8 + wave, NGW = gridDim.x * 8;
  const float* mod = (const float*)(P.ws + WS_MOD); bf16_t* A0 = (bf16_t*)(P.ws + WS_A0); float* rss = (float*)(P.ws + WS_RSS);
  const float* ng = P.in[6];
  for (int r = gw; r < RB; r += NGW) {
    const float* src = r < TL ? P.in[0] + ((size_t)b * TL + r) * D : P.in[2] + ((size_t)b * CL + (r - TL)) * D;
    const int mi = r < TL ? b : 2; const float* scv = mod + (size_t)mi * NMOD + 1024;
    f32x4 v[4]; float ss = 0.f;
#pragma unroll
    for (int j = 0; j < 4; ++j) { v[j] = ((const f32x4*)src)[lane + 64 * j]; ss += (v[j].x * v[j].x + v[j].y * v[j].y) + (v[j].z * v[j].z + v[j].w * v[j].w); }
    ss = wave_sum(ss);
#pragma unroll
    for (int j = 0; j < 4; ++j) { const f32x4 g = ((const f32x4*)ng)[lane + 64 * j], s = ((const f32x4*)scv)[lane + 64 * j]; const f32x4 a = v[j] * g * (s + 1.f);
      u32x2 o; o.x = pk2(a.x, a.y); o.y = pk2(a.z, a.w); *(u32x2*)(A0 + (size_t)r * D + 4 * (lane + 64 * j)) = o; }
    if (lane < 16) rss[(size_t)r * 16 + lane] = lane == 0 ? ss : 0.f;
  }
}
DI void postproc_rows(const Params& P, int l, int tid) {
  const int lane = tid & 63, wave = tid >> 6, gw = blockIdx.x * 8 + wave, NGW = gridDim.x * 8, j = lane & 7;
  bf16_t* Z = (bf16_t*)(P.ws + WS_Z);
  const float* gq = P.in[9] + l * 64; const float* gk = P.in[10] + l * 64; const float* nq = P.in[16] + l * 64; const float* nk = P.in[17] + l * 64;
  u32x4 cur[4], nxt[4];
#pragma unroll
  for (int q = 0; q < 4; ++q) { cur[q] = (u32x4){0u, 0u, 0u, 0u}; nxt[q] = cur[q]; }
  if (gw < RB) {
#pragma unroll
    for (int q = 1; q < 4; q += 2) cur[q] = *(const u32x4*)(Z + (size_t)gw * ZP + (q == 1 ? C_DK : C_NK) + 8 * lane); }
  for (int r = gw; r < RB; r += NGW) {
    if (r + NGW < RB) {
#pragma unroll
      for (int q = 1; q < 4; q += 2) nxt[q] = *(const u32x4*)(Z + (size_t)(r + NGW) * ZP + (q == 1 ? C_DK : C_NK) + 8 * lane); }
    const bool lat = r < TL; float cs[8], sn[8];
    if (lat) { const float pos = (j < 4) ? (float)(r >> 6) : (float)(r & 63);
#pragma unroll
      for (int e = 0; e < 8; ++e) { const int i = 8 * (j & 1) + e; const float freq = __builtin_amdgcn_exp2f(-(float)i * 0.830482023721841f); const float ang = pos * freq;
        const float n = rintf(ang * 0.15915494309189535f); float rr = fmaf(-n, 6.2831855f, ang); rr = fmaf(-n, -1.7484555e-7f, rr); cs[e] = __cosf(rr); sn[e] = __sinf(rr); } }
    else {
#pragma unroll
      for (int e = 0; e < 8; ++e) { cs[e] = 1.f; sn[e] = 0.f; } }
    bf16_t* Zr = Z + (size_t)r * ZP;
#pragma unroll
    for (int pass = 1; pass < 4; pass += 2) {
      const int colbase = pass == 0 ? C_DQ : pass == 1 ? C_DK : pass == 2 ? C_NQ : C_NK;
      const float* g = pass == 0 ? gq : pass == 1 ? gk : pass == 2 ? nq : nk;
      const float scale = (pass == 0 || pass == 2) ? 0.125f * LOG2E : 1.f;
      float v[8]; unpack8(cur[pass], v);
      float ss = 0.f;
#pragma unroll
      for (int e = 0; e < 8; ++e) ss += v[e] * v[e];
      ss += shx(ss, 1); ss += shx(ss, 2); ss += shx(ss, 4);
      const float rstd = rsqrtf(ss * (1.f / 64.f) + EPS) * scale;
      const f32x4 g0 = *(const f32x4*)(g + 8 * j), g1 = *(const f32x4*)(g + 8 * j + 4);
#pragma unroll
      for (int e = 0; e < 4; ++e) { v[e] = v[e] * rstd * g0[e]; v[4 + e] = v[4 + e] * rstd * g1[e]; }
      if (pass < 2 && lat) {
#pragma unroll
        for (int e = 0; e < 8; ++e) { const float p = shx(v[e], 2); v[e] = (j & 2) ? v[e] * cs[e] + p * sn[e] : v[e] * cs[e] - p * sn[e]; } }
      *(u32x4*)(Zr + colbase + 8 * lane) = pack8(v);
    }
#pragma unroll
    for (int q = 0; q < 4; ++q) cur[q] = nxt[q];
  }
}
DI void vt_items(const Params& P, LAS unsigned char* lds, int tid) {
  const int lane = tid & 63, wave = tid >> 6, gw = blockIdx.x * 8 + wave, NGW = gridDim.x * 8;
  const bf16_t* Z = (const bf16_t*)(P.ws + WS_Z);
  LAS bf16_t* scr = (LAS bf16_t*)(lds + wave * 9216);
  for (int it = gw; it < 260 * 16; it += NGW) {
    const int rb = it >> 4, cb = it & 15;
    const int col0 = cb < 8 ? C_DV + 64 * cb : C_NV + 64 * (cb - 8);
    bf16_t* Vt = cb < 8 ? (bf16_t*)(P.ws + WS_VTD) + (size_t)(64 * cb) * RB : (bf16_t*)(P.ws + WS_VTN) + (size_t)(64 * (cb - 8)) * RB;
#pragma unroll
    for (int i = 0; i < 8; ++i) { const int row = 8 * i + (lane >> 3), piece = lane & 7;
      const u32x4 w = *(const u32x4*)(Z + (size_t)(64 * rb + row) * ZP + col0 + 8 * piece);
#pragma unroll
      for (int e = 0; e < 4; ++e) { scr[(8 * piece + 2 * e) * 72 + row] = (bf16_t)(w[e] & 0xffffu); scr[(8 * piece + 2 * e + 1) * 72 + row] = (bf16_t)(w[e] >> 16); } }
    LDS_WAIT();
#pragma unroll
    for (int i = 0; i < 8; ++i) { const int c = 8 * i + (lane >> 3), piece = lane & 7;
      const int t0 = 16 * (piece >> 1) + 4 * (piece & 1);
      const u32x2 lo = *(const LAS u32x2*)(scr + c * 72 + t0), hi = *(const LAS u32x2*)(scr + c * 72 + t0 + 8);
      const u32x4 o = {lo.x, lo.y, hi.x, hi.y};
      *(u32x4*)(Vt + (size_t)c * RB + 64 * rb + 8 * piece) = o; }
    LDS_WAIT();
  }
}
DI void gla_cum8(const Params& P, int l, int h, int dir, const bf16_t* zc, int wave, int lane, float (&cum)[8]) {
  const float* a2 = P.in[13] + ((size_t)(l * 2 + dir) * 16) * 256 + h * 64 + 8 * wave;
  const float* ab = P.in[14] + (size_t)(l * 2 + dir) * 256 + h * 64 + 8 * wave;
  float ga[16];
  { float t[8]; unpack8(*(const u32x4*)(zc + C_GA + dir * 16), t);
#pragma unroll
    for (int e = 0; e < 8; ++e) ga[e] = t[e];
    unpack8(*(const u32x4*)(zc + C_GA + dir * 16 + 8), t);
#pragma unroll
    for (int e = 0; e < 8; ++e) ga[8 + e] = t[e]; }
#pragma unroll
  for (int i = 0; i < 8; ++i) { float z = ab[i];
#pragma unroll
    for (int r = 0; r < 16; ++r) z += ga[r] * a2[r * 256 + i];
    cum[i] = (fminf(z, 0.f) - __logf(1.f + __expf(-fabsf(z)))) * (1.f / 16.f); }
#pragma unroll
  for (int i = 0; i < 8; ++i) { float v = cum[i];
    v += __int_as_float(__builtin_amdgcn_update_dpp(0, __float_as_int(v), 0x111, 0xf, 0xf, false));
    v += __int_as_float(__builtin_amdgcn_update_dpp(0, __float_as_int(v), 0x112, 0xf, 0xf, false));
    v += __int_as_float(__builtin_amdgcn_update_dpp(0, __float_as_int(v), 0x114, 0xf, 0xf, false));
    v += __int_as_float(__builtin_amdgcn_update_dpp(0, __float_as_int(v), 0x118, 0xf, 0xf, false));
    v += __int_as_float(__builtin_amdgcn_update_dpp(0, __float_as_int(v), 0x142, 0xa, 0xf, false));
    v += __int_as_float(__builtin_amdgcn_update_dpp(0, __float_as_int(v), 0x143, 0xc, 0xf, false));
    cum[i] = v; }
}
DI bf16_t bfr(float x) { return (bf16_t)(pk2(x, 0.f) & 0xffffu); }
DI void gla_g1_unit(const Params& P, int l, int u, LAS unsigned char* lds, int tid) {
  const int chain = u / 260, n = u % 260, h = chain >> 1, dir = chain & 1;
  const int rbase = dir == 0 ? (n < 4 ? TL + 64 * n : 64 * (n - 4)) : (n < 4 ? TL + 255 - 64 * n : TL - 1 - 64 * (n - 4));
  const int rstep = dir == 0 ? 1 : -1;
  const int lane = tid & 63, wave = __builtin_amdgcn_readfirstlane(tid >> 6), r = lane & 31, hh = lane >> 5;
  const bf16_t* Z = (const bf16_t*)(P.ws + WS_Z);
  LAS bf16_t* kdT = (LAS bf16_t*)lds; LAS bf16_t* vT = (LAS bf16_t*)(lds + 9216);
  const bf16_t* zc = Z + (size_t)(rbase + rstep * lane) * ZP;
  const u32x4 k8 = *(const u32x4*)(zc + C_GK + h * 64 + 8 * wave);
  const int c2 = tid & 63, piece = tid >> 6;
  const bf16_t* zv = Z + (size_t)(rbase + rstep * c2) * ZP + C_GV + h * 128 + 16 * piece;
  const u32x4 va = *(const u32x4*)zv, vb = *(const u32x4*)(zv + 8);
  float cum[8]; gla_cum8(P, l, h, dir, zc, wave, lane, cum);
  float kf[8]; unpack8(k8, kf);
#pragma unroll
  for (int i = 0; i < 8; ++i) { const float cl = rdl63(cum[i]); kdT[(8 * wave + i) * 72 + lane] = bfr(kf[i] * __expf(cl - cum[i]));
    if (lane == 63) ((float*)(P.ws + WS_DEC))[(size_t)u * 64 + 8 * wave + i] = __expf(cl); }
#pragma unroll
  for (int e = 0; e < 4; ++e) { vT[(16 * piece + 2 * e) * 72 + c2] = (bf16_t)(va[e] & 0xffffu); vT[(16 * piece + 2 * e + 1) * 72 + c2] = (bf16_t)(va[e] >> 16);
    vT[(16 * piece + 8 + 2 * e) * 72 + c2] = (bf16_t)(vb[e] & 0xffffu); vT[(16 * piece + 8 + 2 * e + 1) * 72 + c2] = (bf16_t)(vb[e] >> 16); }
  __syncthreads();
  const int dt = wave >> 2, vt = wave & 3;
  f32x16 acc = zero16();
#pragma unroll
  for (int ks = 0; ks < 4; ++ks) { const bf16x8 a = *(const LAS bf16x8*)(kdT + (32 * dt + r) * 72 + 16 * ks + 8 * hh), bb = *(const LAS bf16x8*)(vT + (32 * vt + r) * 72 + 16 * ks + 8 * hh); acc = MFMA32(a, bb, acc); }
  bf16_t* S = (bf16_t*)(P.ws + WS_S) + (size_t)u * 8192;
#pragma unroll
  for (int i = 0; i < 16; ++i) S[(size_t)(32 * dt + (i & 3) + 8 * (i >> 2) + 4 * hh) * 128 + 32 * vt + r] = bfr(acc[i]);
  __syncthreads();
}
DI void gla_scan(const Params& P, int tid) {
  bf16_t* S = (bf16_t*)(P.ws + WS_S); const float* dec = (const float*)(P.ws + WS_DEC);
  if (tid < 256) for (int gid = blockIdx.x * 256 + tid; gid < 65536; gid += gridDim.x * 256) {
    const int chain = gid >> 13, e = gid & 8191, d = e >> 7;
    bf16_t* Sp = S + (size_t)chain * 260 * 8192 + e; const float* dp = dec + (size_t)chain * 260 * 64 + d; float s = 0.f;
    for (int n0 = 0; n0 < 260; n0 += 10) {
      float ds[10], dc[10];
#pragma unroll
      for (int i = 0; i < 10; ++i) { ds[i] = bf2f(Sp[(size_t)(n0 + i) * 8192]); dc[i] = dp[(n0 + i) * 64]; }
#pragma unroll
      for (int i = 0; i < 10; ++i) { const float prev = s; s = dc[i] * s + ds[i]; ds[i] = prev; }
#pragma unroll
      for (int i = 0; i < 10; ++i) Sp[(size_t)(n0 + i) * 8192] = bfr(ds[i]);
    }
  }
}
DI void gla_g3_unit(const Params& P, int l, int u, LAS unsigned char* lds, int tid) {
  const int h = u / 260, m = u % 260, base = m < 256 ? 64 * m : TL + 64 * (m - 256);
  const int lane = tid & 63, wave = __builtin_amdgcn_readfirstlane(tid >> 6), r = lane & 31, hh = lane >> 5;
  const bf16_t* Z = (const bf16_t*)(P.ws + WS_Z);
  LAS bf16_t* qeL = (LAS bf16_t*)lds; LAS bf16_t* keL = (LAS bf16_t*)(lds + 9216); LAS bf16_t* vT = (LAS bf16_t*)(lds + 18432); LAS bf16_t* ST = (LAS bf16_t*)(lds + 36864);
  LAS float* oL = (LAS float*)(lds + 55296);
  const int c2 = tid >> 3, piece = tid & 7;
  const int cs2 = tid & 63, ps2 = tid >> 6;
  const int pos2 = (cs2 & ~15) | (cs2 & 3) | ((cs2 & 4) << 1) | ((cs2 & 8) >> 1);
  for (int dir = 0; dir < 2; ++dir) {
    const int n = dir == 0 ? (m < 256 ? m + 4 : m - 256) : (m < 256 ? 259 - m : 3 - (m - 256));
    const int rbase = dir == 0 ? base : base + 63, rstep = dir == 0 ? 1 : -1;
    const bf16_t* zc = Z + (size_t)(rbase + rstep * lane) * ZP;
    const u32x4 q8 = *(const u32x4*)(zc + C_GQ + h * 64 + 8 * wave), k8 = *(const u32x4*)(zc + C_GK + h * 64 + 8 * wave);
    const bf16_t* zv = Z + (size_t)(rbase + rstep * cs2) * ZP + C_GV + h * 128 + 16 * ps2;
    const u32x4 va = *(const u32x4*)zv, vb = *(const u32x4*)(zv + 8);
    const bf16_t* Sn = (const bf16_t*)(P.ws + WS_S) + (size_t)((h * 2 + dir) * 260 + n) * 8192 + (size_t)cs2 * 128 + 16 * ps2;
    const u32x4 sa = *(const u32x4*)Sn, sbv = *(const u32x4*)(Sn + 8);
    float cum[8]; gla_cum8(P, l, h, dir, zc, wave, lane, cum);
    { float qf[8], kf[8]; unpack8(q8, qf); unpack8(k8, kf);
#pragma unroll
      for (int i = 0; i < 8; ++i) { const float e = __expf(cum[i]); qf[i] = qf[i] * 0.125f * e; kf[i] = kf[i] * __builtin_amdgcn_rcpf(e); }
      *(LAS u32x4*)(qeL + lane * 72 + 8 * wave) = pack8(qf); *(LAS u32x4*)(keL + lane * 72 + 8 * wave) = pack8(kf); }
#pragma unroll
    for (int e = 0; e < 4; ++e) { vT[(16 * ps2 + 2 * e) * 72 + pos2] = (bf16_t)(va[e] & 0xffffu); vT[(16 * ps2 + 2 * e + 1) * 72 + pos2] = (bf16_t)(va[e] >> 16);
      vT[(16 * ps2 + 8 + 2 * e) * 72 + pos2] = (bf16_t)(vb[e] & 0xffffu); vT[(16 * ps2 + 8 + 2 * e + 1) * 72 + pos2] = (bf16_t)(vb[e] >> 16); }
#pragma unroll
    for (int e = 0; e < 4; ++e) { ST[(16 * ps2 + 2 * e) * 72 + cs2] = (bf16_t)(sa[e] & 0xffffu); ST[(16 * ps2 + 2 * e + 1) * 72 + cs2] = (bf16_t)(sa[e] >> 16);
      ST[(16 * ps2 + 8 + 2 * e) * 72 + cs2] = (bf16_t)(sbv[e] & 0xffffu); ST[(16 * ps2 + 8 + 2 * e + 1) * 72 + cs2] = (bf16_t)(sbv[e] >> 16); }
    __syncthreads();
    const int vt = wave >> 1, ct = wave & 1;
    f32x16 o = zero16();
#pragma unroll
    for (int st = 0; st < 2; ++st) {
      if (st > ct) continue;
      f32x16 x = zero16();
#pragma unroll
      for (int ks = 0; ks < 4; ++ks) { const bf16x8 a = *(const LAS bf16x8*)(keL + (32 * st + r) * 72 + 16 * ks + 8 * hh), bb = *(const LAS bf16x8*)(qeL + (32 * ct + r) * 72 + 16 * ks + 8 * hh); x = MFMA32(a, bb, x); }
      if (st == ct) {
#pragma unroll
        for (int i = 0; i < 16; ++i) if (((i & 3) + 8 * (i >> 2) + 4 * hh) > r) x[i] = 0.f; }
#pragma unroll
      for (int sk = 0; sk < 2; ++sk) { const bf16x8 pb = pack_frag(x, sk); const bf16x8 a = *(const LAS bf16x8*)(vT + (32 * vt + r) * 72 + 32 * st + 16 * sk + 8 * hh); o = MFMA32(a, pb, o); }
    }
#pragma unroll
    for (int ks = 0; ks < 4; ++ks) { const bf16x8 a = *(const LAS bf16x8*)(ST + (32 * vt + r) * 72 + 16 * ks + 8 * hh), bb = *(const LAS bf16x8*)(qeL + (32 * ct + r) * 72 + 16 * ks + 8 * hh); o = MFMA32(a, bb, o); }
    { const int c = 32 * ct + r, lr = dir ? 63 - c : c;
#pragma unroll
      for (int g = 0; g < 4; ++g) { LAS f32x4* p = (LAS f32x4*)(oL + lr * 132 + 32 * vt + 8 * g + 4 * hh); const f32x4 val = {o[4 * g], o[4 * g + 1], o[4 * g + 2], o[4 * g + 3]};
        if (dir == 0) *p = val; else *p = *p + val; } }
    __syncthreads();
  }
  { const int row = base + c2; const float* gn = P.in[15] + l * 128 + 16 * piece; bf16_t* Yg = (bf16_t*)(P.ws + WS_Y + YB);
    const LAS f32x4* op = (const LAS f32x4*)(oL + c2 * 132 + 16 * piece);
    f32x4 ov[4]; float ss = 0.f;
#pragma unroll
    for (int q = 0; q < 4; ++q) { ov[q] = op[q]; ss += (ov[q].x * ov[q].x + ov[q].y * ov[q].y) + (ov[q].z * ov[q].z + ov[q].w * ov[q].w); }
    ss += shx(ss, 1); ss += shx(ss, 2); ss += shx(ss, 4);
    const float rstd = rsqrtf(ss * (1.f / 128.f) + EPS);
    float g[16]; { float t[8]; const bf16_t* gp = Z + (size_t)row * ZP + C_GG + h * 128 + 16 * piece; unpack8(*(const u32x4*)gp, t);
#pragma unroll
      for (int e = 0; e < 8; ++e) g[e] = t[e];
      unpack8(*(const u32x4*)(gp + 8), t);
#pragma unroll
      for (int e = 0; e < 8; ++e) g[8 + e] = t[e]; }
    float y[16];
#pragma unroll
    for (int q = 0; q < 4; ++q) { const f32x4 gv = *(const f32x4*)(gn + 4 * q);
#pragma unroll
      for (int e = 0; e < 4; ++e) { const float gg = g[4 * q + e]; y[4 * q + e] = ov[q][e] * rstd * gv[e] * gg * sigm(gg); } }
    float y0[8], y1[8];
#pragma unroll
    for (int e = 0; e < 8; ++e) { y0[e] = y[e]; y1[e] = y[8 + e]; }
    bf16_t* yp = Yg + (size_t)row * 512 + h * 128 + 16 * piece; *(u32x4*)yp = pack8(y0); *(u32x4*)(yp + 8) = pack8(y1); }
}
DI void q_norm_rope(const u32x4 (&raw)[4], const float* g, float scale, bool rope, int token, int hh, bf16x8 (&out)[4]) {
  float v[4][8]; float ss = 0.f;
#pragma unroll
  for (int ks = 0; ks < 4; ++ks) { unpack8(raw[ks], v[ks]);
#pragma unroll
    for (int j = 0; j < 8; ++j) ss += v[ks][j] * v[ks][j]; }
  ss += shx(ss, 32);
  const float rstd = rsqrtf(ss * (1.f / 64.f) + EPS) * scale;
#pragma unroll
  for (int ks = 0; ks < 4; ++ks) { const f32x4 g0 = *(const f32x4*)(g + 16 * ks + 8 * hh), g1 = *(const f32x4*)(g + 16 * ks + 8 * hh + 4);
#pragma unroll
    for (int j = 0; j < 4; ++j) { v[ks][j] *= rstd * g0[j]; v[ks][4 + j] *= rstd * g1[j]; } }
  if (rope) { const float prow = (float)(token >> 6), pcol = (float)(token & 63);
#pragma unroll
    for (int j = 0; j < 8; ++j) { const float freq = __builtin_amdgcn_exp2f(-(float)(8 * hh + j) * 0.830482023721841f);
#pragma unroll
      for (int half = 0; half < 2; ++half) { const float ang = (half ? pcol : prow) * freq;
        const float n = rintf(ang * 0.15915494309189535f); float rr = fmaf(-n, 6.2831855f, ang); rr = fmaf(-n, -1.7484555e-7f, rr); const float c = __cosf(rr), sn = __sinf(rr);
        const float x1 = v[2 * half][j], x2 = v[2 * half + 1][j]; v[2 * half][j] = x1 * c - x2 * sn; v[2 * half + 1][j] = x1 * sn + x2 * c; } } }
#pragma unroll
  for (int ks = 0; ks < 4; ++ks) out[ks] = __builtin_bit_cast(bf16x8, pack8(v[ks]));
}
constexpr int NA_TAB_BYTES = 15392, NA_STAGE_BYTES = 65536, NA_VOFF = 32768;
DI void na_issue_tile(const bf16_t* Z, const bf16_t* Vt, int hg, int key0, LAS unsigned char* stage, int wave, int lane) {
#pragma unroll
  for (int i = 0; i < 4; ++i) { const int blk = 4 * wave + i, row = 2 * blk + (lane >> 5), slot = lane & 31, piece = (slot & 16) | ((slot & 15) ^ (row & 15));
    const bf16_t* g = Z + (size_t)(key0 + row) * ZP + C_NK + hg * 256 + piece * 8;
    __builtin_amdgcn_global_load_lds((const unsigned*)g, (LAS unsigned*)(stage + blk * 1024), 16, 0, 0); }
#pragma unroll
  for (int i = 0; i < 4; ++i) { const int blk = 4 * wave + i, row = 8 * blk + (lane >> 3), piece = (lane & 7) ^ ((row >> 1) & 7);
    const bf16_t* g = Vt + (size_t)(hg * 256 + row) * RB + key0 + piece * 8;
    __builtin_amdgcn_global_load_lds((const unsigned*)g, (LAS unsigned*)(stage + NA_VOFF + blk * 1024), 16, 0, 0); }
}
DI void na_block_unit(const Params& P, int l, int bu, LAS unsigned char* lds, int tid) {
  const int lane = tid & 63, wave = __builtin_amdgcn_readfirstlane(tid >> 6), r = lane & 31, hh = lane >> 5, hl = wave >> 1, qh = wave & 1;
  const bf16_t* Z = (const bf16_t*)(P.ws + WS_Z); const bf16_t* Vt = (const bf16_t*)(P.ws + WS_VTN); bf16_t* Yn = (bf16_t*)(P.ws + WS_Y + 2 * YB);
  const LAS float* rpbL = (const LAS float*)lds;
  int hg, gr, qrow0, nt; bool latq;
  if (bu < 512) { hg = bu & 1; gr = bu >> 1; qrow0 = gr * 64; nt = 12; latq = true; } else { const int uu = bu - 512; hg = uu & 1; gr = 0; qrow0 = TL + 64 * (uu >> 1); nt = 4; latq = false; }
  const int h = 4 * hg + hl, w = 32 * qh + r, qrow = qrow0 + w;
  const int rs = min(max(gr - 4, 0), 248), cs = min(max(w - 8, 0), 48);
  const int lanec = 15 - w + 4 * hh, csl = cs - 4 * hh;
  LAS unsigned char* st0 = lds + NA_TAB_BYTES;
  na_issue_tile(Z, Vt, hg, latq ? rs * 64 : TL, st0, wave, lane);
  bf16x8 bq[4]; u32x4 braw[4];
#pragma unroll
  for (int ks = 0; ks < 4; ++ks) braw[ks] = *(const u32x4*)(Z + (size_t)qrow * ZP + C_NQ + h * 64 + 16 * ks + 8 * hh);
  q_norm_rope(braw, P.in[16] + l * 64, 0.125f * LOG2E, false, 0, hh, bq);
  const int mk = r & 15, mv = (r >> 1) & 7;
  const int kfr = r * 512 + (hl >> 1) * 256, vfr = NA_VOFF + (hl * 64 + r) * 128;
  f32x16 o[2]; o[0] = zero16(); o[1] = zero16(); float lsum = 0.f;
  asm volatile("s_waitcnt vmcnt(0)" ::: "memory");
  __syncthreads();
  for (int ti = 0; ti < nt; ++ti) {
    const int cur = ti & 1; const bool band = latq && ti < 8;
    if (ti + 1 < nt) { const int tn = ti + 1; const int keyn = (latq && tn < 8) ? (rs + tn) * 64 : TL + 64 * (latq ? tn - 8 : tn);
      na_issue_tile(Z, Vt, hg, keyn, st0 + (cur ^ 1) * NA_STAGE_BYTES, wave, lane); }
    const LAS unsigned char* sb = st0 + cur * NA_STAGE_BYTES;
    const int relrow = rs + ti - gr + 7;
    const LAS float* tb = rpbL + 64 + (h * 15 + (band ? relrow : 0)) * 31 + lanec;
#pragma unroll
    for (int st = 0; st < 2; ++st) {
      f32x16 s = zero16();
#pragma unroll
      for (int ks = 0; ks < 4; ++ks) { const bf16x8 a = *(const LAS bf16x8*)(sb + kfr + st * (32 * 512) + (((8 * (hl & 1) + 2 * ks + hh) ^ mk) << 4)); s = MFMA32(a, bq[ks], s); }
      if (band) {
        const bool few = (st == 1) ? (qh == 0) : (qh == 1);
        if (few) {
#pragma unroll
          for (int i = 0; i < 16; ++i) { const int c = 32 * st + (i & 3) + 8 * (i >> 2); const bool live = (st == 1) ? ((i >> 2) == 0) : ((i >> 2) == 3);
            if (live) { const float e = __builtin_amdgcn_exp2f(s[i] + tb[c]); const float p = ((unsigned)(c - csl) < 16u) ? e : 0.f; lsum += p; s[i] = p; } else s[i] = 0.f; }
        } else {
#pragma unroll
          for (int i = 0; i < 16; ++i) { const int c = 32 * st + (i & 3) + 8 * (i >> 2);
            const float e = __builtin_amdgcn_exp2f(s[i] + tb[c]); const float p = ((unsigned)(c - csl) < 16u) ? e : 0.f; lsum += p; s[i] = p; }
        }
      } else {
#pragma unroll
        for (int i = 0; i < 16; ++i) { const float p = __builtin_amdgcn_exp2f(s[i]); lsum += p; s[i] = p; }
      }
#pragma unroll
      for (int s2 = 0; s2 < 2; ++s2) { const bf16x8 pb = pack_frag(s, s2);
#pragma unroll
        for (int dvt = 0; dvt < 2; ++dvt) { const bf16x8 a = *(const LAS bf16x8*)(sb + vfr + dvt * (32 * 128) + (((4 * st + 2 * s2 + hh) ^ mv) << 4)); o[dvt] = MFMA32(a, pb, o[dvt]); } }
    }
    asm volatile("s_waitcnt vmcnt(0)" ::: "memory");
    __syncthreads();
  }
  lsum += shx(lsum, 32);
  const float inv = 1.f / lsum;
#pragma unroll
  for (int dvt = 0; dvt < 2; ++dvt)
#pragma unroll
    for (int g = 0; g < 4; ++g) { u32x2 wv; wv.x = pk2(o[dvt][4 * g] * inv, o[dvt][4 * g + 1] * inv); wv.y = pk2(o[dvt][4 * g + 2] * inv, o[dvt][4 * g + 3] * inv);
      *(u32x2*)(Yn + (size_t)qrow * 512 + h * 64 + 32 * dvt + 8 * g + 4 * hh) = wv; }
}
constexpr int DA_STAGE0 = 65536, DA_STAGE_BYTES = 32768, DA_VOFF = 16384;
DI void da_issue_tile(const bf16_t* Z, const bf16_t* Vt, int h, int key0, LAS unsigned char* stage, int wave, int lane) {
#pragma unroll
  for (int i = 0; i < 2; ++i) { const int row = 4 * (2 * wave + i) + (lane >> 4), piece = (lane & 15) ^ (row & 15);
    const bf16_t* g = Z + (size_t)(key0 + row) * ZP + C_DK + h * 128 + piece * 8;
    __builtin_amdgcn_global_load_lds((const unsigned*)g, (LAS unsigned*)(stage + (2 * wave + i) * 1024), 16, 0, 0); }
#pragma unroll
  for (int i = 0; i < 2; ++i) { const int row = 8 * (2 * wave + i) + (lane >> 3), piece = (lane & 7) ^ ((row >> 1) & 7);
    const bf16_t* g = Vt + (size_t)(h * 128 + row) * RB + key0 + piece * 8;
    __builtin_amdgcn_global_load_lds((const unsigned*)g, (LAS unsigned*)(stage + DA_VOFF + (2 * wave + i) * 1024), 16, 0, 0); }
}
DI void da_unit(const Params& P, int l, int u, float lam, float lam_init, LAS unsigned char* lds, int tid) {
  const int lane = tid & 63, wave = __builtin_amdgcn_readfirstlane(tid >> 6), r = lane & 31, hh = lane >> 5, pr = wave >> 1, sidx = wave & 1;
  const bf16_t* Z = (const bf16_t*)(P.ws + WS_Z); const bf16_t* Vt = (const bf16_t*)(P.ws + WS_VTD); bf16_t* Yd = (bf16_t*)(P.ws + WS_Y);
  int h, q0, t0, t1;
  if (u < 256) { h = u & 3; q0 = (u >> 2) * 256; t0 = 0; t1 = 260; } else { h = u - 256; q0 = TL; t0 = 256; t1 = 260; }
  const int qrow = q0 + 64 * pr + r;
  da_issue_tile(Z, Vt, h, 64 * t0, lds + DA_STAGE0, wave, lane);
  bf16x8 qA[4]; u32x4 rawA[4], rawB[4];
  LAS bf16x8* qL = (LAS bf16x8*)(lds + wave * 4096) + lane;
#pragma unroll
  for (int ks = 0; ks < 4; ++ks) { const bf16_t* qp = Z + (size_t)qrow * ZP + C_DQ + h * 128 + 64 * sidx + 16 * ks + 8 * hh; rawA[ks] = *(const u32x4*)qp; rawB[ks] = *(const u32x4*)(qp + (size_t)32 * ZP); }
  { const float* gq = P.in[9] + l * 64; const bool lat = u < 256; bf16x8 qB[4];
    q_norm_rope(rawA, gq, 0.125f * LOG2E, lat, qrow, hh, qA); q_norm_rope(rawB, gq, 0.125f * LOG2E, lat, qrow + 32, hh, qB);
#pragma unroll
    for (int ks = 0; ks < 4; ++ks) qL[ks * 64] = qB[ks]; }
  const int mk = r & 15, mv = (r >> 1) & 7;
  const int kfr = r * 256, vfr = DA_VOFF + r * 128;
  asm volatile("s_waitcnt vmcnt(0)" ::: "memory");
  __syncthreads();
  f32x16 oA[4], oB[4];
#pragma unroll
  for (int i = 0; i < 4; ++i) { oA[i] = zero16(); oB[i] = zero16(); }
  float lA = 0.f, lB = 0.f;
  for (int t = t0; t < t1; ++t) {
    const int cur = (t - t0) & 1;
    if (t + 1 < t1) da_issue_tile(Z, Vt, h, 64 * (t + 1), lds + DA_STAGE0 + (cur ^ 1) * DA_STAGE_BYTES, wave, lane);
    const LAS unsigned char* sb = lds + DA_STAGE0 + cur * DA_STAGE_BYTES;
#pragma unroll 2
    for (int st = 0; st < 2; ++st) {
      bf16x8 pA[2], pB[2];
      const LAS unsigned char* kf = sb + kfr + st * (32 * 256);
      { f32x16 sA = zero16(), sB = zero16();
#pragma unroll
        for (int ks = 0; ks < 4; ++ks) { const bf16x8 a = *(const LAS bf16x8*)(kf + (((8 * sidx + 2 * ks + hh) ^ mk) << 4)); sA = MFMA32(a, qA[ks], sA); sB = MFMA32(a, qL[ks * 64], sB); }
#pragma unroll
        for (int i = 0; i < 16; ++i) { sA[i] = __builtin_amdgcn_exp2f(sA[i]); lA += sA[i]; }
        pA[0] = pack_frag(sA, 0); pA[1] = pack_frag(sA, 1);
        __builtin_amdgcn_sched_barrier(0);
#pragma unroll
        for (int i = 0; i < 16; ++i) { sB[i] = __builtin_amdgcn_exp2f(sB[i]); lB += sB[i]; }
        pB[0] = pack_frag(sB, 0); pB[1] = pack_frag(sB, 1); }
      const LAS unsigned char* vf = sb + vfr;
#pragma unroll
      for (int sk = 0; sk < 2; ++sk) {
#pragma unroll
        for (int dvt = 0; dvt < 4; ++dvt) { const bf16x8 a = *(const LAS bf16x8*)(vf + dvt * (32 * 128) + (((4 * st + 2 * sk + hh) ^ mv) << 4)); oA[dvt] = MFMA32(a, pA[sk], oA[dvt]); oB[dvt] = MFMA32(a, pB[sk], oB[dvt]); } }
    }
    asm volatile("s_waitcnt vmcnt(0)" ::: "memory");
    __syncthreads();
  }
  const int qrow_e = q0 + 64 * pr + (lane & 31) + opaque_zero();
  lA += shx(lA, 32); lB += shx(lB, 32);
  LAS float* xq = (LAS float*)lds + (size_t)pr * (64 * 132);
  if (sidx == 1) { const float iA = lam / lA, iB = lam / lB;
#pragma unroll
    for (int dvt = 0; dvt < 4; ++dvt)
#pragma unroll
      for (int g = 0; g < 4; ++g) { const int dv = 32 * dvt + 8 * g + 4 * hh;
        *(LAS f32x4*)(xq + r * 132 + dv) = (f32x4){oA[dvt][4 * g] * iA, oA[dvt][4 * g + 1] * iA, oA[dvt][4 * g + 2] * iA, oA[dvt][4 * g + 3] * iA};
        *(LAS f32x4*)(xq + (32 + r) * 132 + dv) = (f32x4){oB[dvt][4 * g] * iB, oB[dvt][4 * g + 1] * iB, oB[dvt][4 * g + 2] * iB, oB[dvt][4 * g + 3] * iB}; } }
  __syncthreads();
  if (sidx == 0) { const float iA = 1.f / lA, iB = 1.f / lB; float ssA = 0.f, ssB = 0.f;
#pragma unroll
    for (int dvt = 0; dvt < 4; ++dvt)
#pragma unroll
      for (int g = 0; g < 4; ++g) { const int dv = 32 * dvt + 8 * g + 4 * hh; const f32x4 xa = *(const LAS f32x4*)(xq + r * 132 + dv), xb = *(const LAS f32x4*)(xq + (32 + r) * 132 + dv);
#pragma unroll
        for (int e = 0; e < 4; ++e) { const float va = oA[dvt][4 * g + e] * iA - xa[e], vb = oB[dvt][4 * g + e] * iB - xb[e]; oA[dvt][4 * g + e] = va; oB[dvt][4 * g + e] = vb; ssA += va * va; ssB += vb * vb; }  }
    ssA += shx(ssA, 32); ssB += shx(ssB, 32);
    const float oml = __uint_as_float(__builtin_amdgcn_readfirstlane(__float_as_uint(1.f - lam_init)));
    const float rA = rsqrtf(ssA * (1.f / 128.f) + EPS) * oml, rB = rsqrtf(ssB * (1.f / 128.f) + EPS) * oml;
    const float* sg = P.in[12] + l * 128;
#pragma unroll
    for (int dvt = 0; dvt < 4; ++dvt)
#pragma unroll
      for (int g = 0; g < 4; ++g) { const int dv = 32 * dvt + 8 * g + 4 * hh; const f32x4 gv = *(const f32x4*)(sg + dv);
        u32x2 w; w.x = pk2(oA[dvt][4 * g] * rA * gv.x, oA[dvt][4 * g + 1] * rA * gv.y); w.y = pk2(oA[dvt][4 * g + 2] * rA * gv.z, oA[dvt][4 * g + 3] * rA * gv.w);
        *(u32x2*)(Yd + (size_t)qrow_e * 512 + h * 128 + dv) = w;
        u32x2 w2; w2.x = pk2(oB[dvt][4 * g] * rB * gv.x, oB[dvt][4 * g + 1] * rB * gv.y); w2.y = pk2(oB[dvt][4 * g + 2] * rB * gv.z, oB[dvt][4 * g + 3] * rB * gv.w);
        *(u32x2*)(Yd + (size_t)(qrow_e + 32) * 512 + h * 128 + dv) = w2; } }
  __syncthreads();
}
#ifndef ONLY
#define ONLY -1
#endif
#define ON(k) (ONLY < 0 || ONLY == (k))
__global__ void __launch_bounds__(512) mk_fwd(Params P) {
  extern __shared__ __attribute__((aligned(16))) unsigned char lds_raw[];
  LAS unsigned char* lds = (LAS unsigned char*)lds_raw;
  cg::grid_group grid = cg::this_grid();
  const int tid0 = threadIdx.x, G = gridDim.x, bx = blockIdx.x;
#define tid (tid0 + opaque_zero())
  unsigned char* ws = P.ws;
  const float* mod = (const float*)(ws + WS_MOD);
  bf16_t* A0 = (bf16_t*)(ws + WS_A0); bf16_t* Mb = A0; bf16_t* A1 = (bf16_t*)(ws + WS_Y);
  bf16_t* Zb = (bf16_t*)(ws + WS_Z); bf16_t* Hb = Zb; float* rss = (float*)(ws + WS_RSS);

  if (bx == 0) for (int i = tid; i < XCD_BAR_WORDS; i += 512) ((unsigned*)(ws + WS_BAR))[i] = 0u;
  if (ON(0)) phase_mod(P, lds, tid);
  if (ON(1)) phase_convert(P, lds, tid);
  grid.sync();
  volatile LAS unsigned* xst = (volatile LAS unsigned*)(lds + 147440);
  if (tid0 < 2) xst[tid0] = 0u;
  __syncthreads();
  const XcdBarrier xbar = xcd_barrier_post((unsigned*)(ws + WS_BAR), xst);
  for (int b = 0; b < 2; ++b) {
    float* xsLat = P.out + (size_t)b * TL * D; float* xsCtx = (float*)(ws + WS_XSC) + (size_t)b * CL * D;
    for (int l = 0; l < 2; ++l) {
      const bf16_t* WL = (const bf16_t*)(ws + WS_W + (size_t)l * WL_BYTES);
      const float* modl = mod + (size_t)l * 3 * NMOD;
      const int Mrest = (l == 0) ? RB : TL;
      if (l == 0) { if (b == 0 && ON(2)) phase_bias(P, tid); if (ON(3)) phase_prep(P, b, tid); xcd_barrier(xbar); }
      if (ON(4)) { pg8::Gemm g{A0, WL + OFF_WIN, RB, NZ, D}; pg8::StaticOrder S; S.init(RB, NZ, G, bx);
        EpiZ E{Zb, rss, (const float*)(ws + WS_BIN) + (size_t)l * 3 * NZ, b};
        pg8::gemm_phase<EpiZ, pg8::StaticOrder, true, true>(lds, g, S, E); }
      xcd_barrier(xbar);
      if (ON(5)) postproc_rows(P, l, tid);
      if (ON(6)) vt_items(P, lds, tid);
      __syncthreads();
      if (ON(7)) for (int u = bx; u < 8 * 260; u += G) gla_g1_unit(P, l, u, lds, tid);
      xcd_barrier(xbar);
      if (ON(8)) gla_scan(P, tid);
      if (ON(9)) { LAS float* rpbL = (LAS float*)lds; const float* rpb = P.in[18] + (size_t)l * 8 * 15 * 31;
        for (int i = tid; i < 8 * 15 * 31 + 128; i += 512) rpbL[i] = (i >= 64 && i < 64 + 8 * 15 * 31) ? rpb[i - 64] * LOG2E : 0.f;
        __syncthreads();
        const int nbu = (l == 0) ? 512 + 8 : 512;
        if ((G & 7) == 0) {
          const int gx = G >> 3, xcd = bx & 7, li = bx >> 3;
          for (int k = 0; k <= 64 / gx + 1; ++k) { const int jj = li + gx * k; int bu = -1;
            if (jj < 64) bu = xcd * 64 + jj; else if (jj - 64 < 1 && 512 + xcd < nbu && li == (64 % gx)) bu = 512 + xcd;
            if (bu >= 0) na_block_unit(P, l, bu, lds, tid); }
        } else for (int bu = bx; bu < nbu; bu += G) na_block_unit(P, l, bu, lds, tid);
      }
      xcd_barrier(xbar);
      { const float* lp = P.in[11] + (size_t)l * 256; float d0 = 0.f, d1 = 0.f;
        for (int i = 0; i < 64; ++i) { d0 += lp[i] * lp[64 + i]; d1 += lp[128 + i] * lp[192 + i]; }
        const float lam_init_v = 0.8f - 0.6f * __expf(-0.3f * (float)l); const float lam_v = __expf(d0) - __expf(d1) + lam_init_v;
        const float lam_init = __uint_as_float(__builtin_amdgcn_readfirstlane(__float_as_uint(lam_init_v))), lam = __uint_as_float(__builtin_amdgcn_readfirstlane(__float_as_uint(lam_v)));
        const int nda = (l == 0) ? 260 : 256;
        if (ON(10)) for (int k = 0; k < 2; ++k) { int u = -1;
          if (G >= 256) { if (k == 0) { if (bx < 256) u = bx; } else if (l == 0 && bx >= G - 4) u = 256 + (bx - (G - 4)); }
          else { u = bx + k * G; if (u >= nda) u = -1; }
          if (u >= 0) da_unit(P, l, u, lam, lam_init, lds, tid); }
        __syncthreads();
        if (ON(11)) for (int u = bx; u < 4 * 260; u += G) { if (l == 1 && (u % 260) >= 256) continue; gla_g3_unit(P, l, u, lds, tid); }
      }
      xcd_barrier(xbar);
      if (ON(12)) for (int step = 0; step < 3; ++step) {
        const bf16_t* Yb = (const bf16_t*)(ws + WS_Y + (size_t)step * YB);
        pg8::Gemm g{Yb, WL + OFF_BR + (size_t)step * 524288, Mrest, D, 512}; pg8::StaticOrder S; S.init(Mrest, D, G, bx);
        EpiMerge E{Zb, Mb, step};
        pg8::gemm_phase<EpiMerge, pg8::StaticOrder, true, true>(lds, g, S, E);
      }
      xcd_barrier(xbar);
      if (ON(13)) { pg8::Gemm g{Mb, WL + OFF_OUT, Mrest, D, D}; pg8::StaticOrder S; S.init(Mrest, D, G, bx);
        const float* inLat = (l == 0) ? P.in[0] + (size_t)b * TL * D : xsLat; const float* inCtx = (l == 0) ? P.in[2] + (size_t)b * CL * D : xsCtx;
        EpiRes E{inLat, inCtx, xsLat, xsCtx, modl + 2048, P.in[7] + (size_t)l * D, modl + 4096, A1, rss, b};
        pg8::gemm_phase<EpiRes, pg8::StaticOrder, true, true>(lds, g, S, E); }
      xcd_barrier(xbar);
      unsigned* cflag = (unsigned*)(ws + WS_BAR) + 16 + 16 * b;
      const bool l0 = (l == 0) && G >= 64;
      const bool l0plain = (l == 0) && !l0;
      if (ON(14)) for (int pass = 0; pass < 2; ++pass) {
        pg8::Gemm g{A1, WL + OFF_W1, Mrest, FF, D}; pg8::StaticOrder S;
        if (pass == 0) S.init_one((l0 && bx >= 16 && bx < 32) ? 64 : -2, bx - 16);
        else if (l0) { if (bx < G - 4) S.init(TL, FF, G - 4, bx); else S.init_one(-2, 0); }
        else S.init(l0plain ? RB : TL, FF, G, bx);
        EpiF1 E{Hb, rss, (const float*)(ws + WS_BF1) + (size_t)l * 3 * FF, b};
        pg8::gemm_phase<EpiF1, pg8::StaticOrder, true, true>(lds, g, S, E);
        if (pass == 0 && l0 && bx >= 16 && bx < 32) {
          asm volatile("s_waitcnt vmcnt(0)" ::: "memory"); __syncthreads();
          if (threadIdx.x == 0) { __builtin_amdgcn_fence(__ATOMIC_RELEASE, "agent"); asm volatile("s_waitcnt vmcnt(0)" ::: "memory"); (void)xb_add(cflag, 1u); }
        }
      }
      if (ON(15)) for (int part = 0; part < 2; ++part) {
        pg8::Gemm g{Hb, WL + OFF_W2, Mrest, D, FF}; pg8::StaticOrder S;
        if (part == 0) {
          const bool mine = l0 && bx >= G - 4;
          if (mine) {
            if (threadIdx.x == 0) { unsigned sp = 0; while (xb_ld(cflag) < 16u && ++sp < (1u << 22)) __builtin_amdgcn_s_sleep(2);
              __builtin_amdgcn_fence(__ATOMIC_ACQUIRE, "agent"); asm volatile("s_waitcnt vmcnt(0)" ::: "memory"); }
            __syncthreads();
          }
          S.init_one(mine ? 64 : -2, bx - (G - 4));
        } else S.init(l0plain ? RB : TL, D, G, bx);
        EpiRes E{xsLat, xsCtx, xsLat, xsCtx, modl + 5120, (l == 0) ? P.in[6] + D : nullptr, mod + (size_t)3 * NMOD + 1024, (l == 0) ? A0 : nullptr, rss, b};
        pg8::gemm_phase<EpiRes, pg8::StaticOrder, true, true>(lds, g, S, E);
        if (part == 0) xcd_barrier(xbar);
      }
      if (!(b == 1 && l == 1)) xcd_barrier(xbar);
    }
  }
}

#undef tid
extern "C" void kernel_launch(void* const* d_in, const int* in_sizes, int n_in, void* d_out, int out_size, void* d_ws, size_t ws_size, hipStream_t stream) {
  static int grid = 0; constexpr int LDSB = 147456;
  if (grid == 0) {
    if (n_in != 25 || out_size != 2 * TL * D || ws_size < WS_END) { fprintf(stderr, "kernel_launch: unexpected problem (n_in %d out %d ws %zu need %zu)\n", n_in, out_size, ws_size, (size_t)WS_END); grid = -1; return; }
    int dev = 0, cus = 0, per = 0;
    (void)hipGetDevice(&dev); (void)hipDeviceGetAttribute(&cus, hipDeviceAttributeMultiprocessorCount, dev);
    (void)hipFuncSetAttribute((const void*)mk_fwd, hipFuncAttributeMaxDynamicSharedMemorySize, LDSB);
    (void)hipOccupancyMaxActiveBlocksPerMultiprocessor(&per, (const void*)mk_fwd, 512, LDSB);
    if (per < 1) per = 1;
    grid = cus * per;
  }
  if (grid < 0) return;
  Params p{};
  for (int i = 0; i < 25; ++i) p.in[i] = (const float*)d_in[i];
  p.out = (float*)d_out; p.ws = (unsigned char*)d_ws;
  void* args[] = {&p};
  hipError_t e = hipLaunchCooperativeKernel((const void*)mk_fwd, dim3(grid), dim3(512), args, LDSB, stream);
  if (e != hipSuccess) fprintf(stderr, "cooperative launch failed: %s (grid %d)\n", hipGetErrorString(e), grid);
}
```

```cpp
#include <hip/hip_runtime.h>
#include <hip/hip_cooperative_groups.h>
#include <cstdio>
#include <cstdint>
namespace cg = cooperative_groups;
__device__ __forceinline__ int opaque_zero() { int z; asm volatile("v_mov_b32 %0, 0" : "=v"(z)); return z; }
namespace pg8 {
#define PG8_LAS __attribute__((address_space(3)))
typedef unsigned short bf16_t;
typedef short bf16x8 __attribute__((ext_vector_type(8)));
typedef float f32x4 __attribute__((ext_vector_type(4)));
typedef unsigned u32x4 __attribute__((ext_vector_type(4)));
constexpr int BM = 256, BK = 64, HALF = 128, HTB = HALF * BK * 2  , STAGE_BYTES = 8 * HTB, NXCD = 8, WGM = 8;

__host__ __device__ __forceinline__ int lds_byte(int r, int c) { const int st = (r >> 4) * 2 + (c >> 5), rr = r & 15, cc = c & 31, ob = rr * 64 + cc * 2; return st * 1024 + (ob ^ (((ob >> 9) & 1) << 5)); }
__host__ __device__ __forceinline__ void stage_rc(int b, int& R, int& C) { const int st = b / 1024, sb = b % 1024, swz = sb ^ (((sb >> 9) & 1) << 5); R = (st >> 1) * 16 + swz / 64; C = (st & 1) * 32 + (swz % 64) / 2; }
__host__ __device__ __forceinline__ int perm32(int rho) { const int n = rho >> 4, i = rho & 15; return 8 * (i >> 2) + 4 * n + (i & 3); }

struct Unit { int pm, pn; };
struct Gemm { const bf16_t* A; const bf16_t* Bt; int M, N, K; };

struct StaticOrder {
    int nM, nN, nwg, G, c, fpm, fpn;
    __host__ __device__ void init(int M, int N, int G_, int c_) { nM = M / BM; nN = N / BM; nwg = nM * nN; G = G_; c = c_; fpm = -1; fpn = 0; }
    __host__ __device__ void init_one(int pm, int pn) { nM = 1; nN = 1; nwg = 1; G = 1; c = 0; fpm = pm; fpn = pn; }
    __host__ __device__ bool next(int i, Unit& u) const {
        if (fpm != -1) { if (i != 0 || fpm < 0) return false; u.pm = fpm; u.pn = fpn; return true; }
        const long L = (long)i * G + c; if (L >= nwg) return false;
        int wgid = (int)L; { const int q = nwg / NXCD, r = nwg % NXCD, xcd = wgid % NXCD, off = wgid / NXCD; wgid = (xcd < r ? xcd * (q + 1) : r * (q + 1) + (xcd - r) * q) + off; }
        const int nig = WGM * nN, gid = wgid / nig, fm = gid * WGM, gsz = (nM - fm) < WGM ? (nM - fm) : WGM;
        u.pm = fm + ((wgid % nig) % gsz); u.pn = (wgid % nig) / gsz; return true;
    }
    __device__ __forceinline__ void a_ready(const Unit&) const {}
    __device__ __forceinline__ void done(const Unit&) const {}
};

__device__ __forceinline__ unsigned cvt_pk_bf16(float lo, float hi) { unsigned r; asm volatile("v_cvt_pk_bf16_f32 %0, %1, %2" : "=v"(r) : "v"(lo), "v"(hi)); return r; }
template <class Epi, class Sched, bool ALIGN_EPI = false, bool SP2 = false>
__device__ __forceinline__ void gemm_phase(PG8_LAS unsigned char* lds, const Gemm g, const Sched& S, const Epi& E) {
    const int tid = (int)threadIdx.x + opaque_zero(), wid = __builtin_amdgcn_readfirstlane(tid >> 6), lane = tid & 63, wr = wid >> 2, wc = wid & 3, fr = lane & 15, fq = lane >> 4;
    const int K = g.K, nt = K / BK;
    unsigned voffA[2], voffB[2];
#pragma unroll
    for (int i = 0; i < 2; ++i) { int R, C; stage_rc(tid * 16 + i * 8192, R, C); const int Rb = Epi::PERM ? ((R & ~31) + perm32(R & 31)) : R;
        voffA[i] = (unsigned)(R * K + C) * 2u; voffB[i] = (unsigned)(Rb * K + C) * 2u; }
    const size_t kstep = (size_t)(BK * 2);
    const size_t hstep = (size_t)HALF * K * 2;
    const size_t tstep = 2 * hstep;
    const unsigned ldsw = (unsigned)wid * 1024u;
    const int aoff = lds_byte(wr * 64 + fr, fq * 8), boff = lds_byte(wc * 32 + fr, fq * 8);
#define PG8_SA(b, h) (((b) * 2 + (h)) * HTB)
#define PG8_SB(b, h) ((4 + (b) * 2 + (h)) * HTB)
#define PG8_STAGE(bufoff, gbase, voff) do { _Pragma("unroll") for (int _i = 0; _i < 2; ++_i) \
        __builtin_amdgcn_global_load_lds((const unsigned*)((const char*)(gbase) + (voff)[_i]), (PG8_LAS unsigned*)(lds + (bufoff) + ldsw + _i * 8192), 16, 0, 0); } while (0)
#define PG8_LDA(dst, b, h) do { _Pragma("unroll") for (int m = 0; m < 4; ++m) _Pragma("unroll") for (int k = 0; k < 2; ++k) dst[m][k] = *(const PG8_LAS bf16x8*)(lds + PG8_SA(b, h) + aoff + m * 2048 + k * 1024); } while (0)
#define PG8_LDB(dst, b, h) do { _Pragma("unroll") for (int n = 0; n < 2; ++n) _Pragma("unroll") for (int k = 0; k < 2; ++k) dst[n][k] = *(const PG8_LAS bf16x8*)(lds + PG8_SB(b, h) + boff + n * 2048 + k * 1024); } while (0)
#define PG8_MMA(ai, bj, At, Bt) do { __builtin_amdgcn_s_setprio(1); _Pragma("unroll") for (int m = 0; m < 4; ++m) _Pragma("unroll") for (int n = 0; n < 2; ++n) _Pragma("unroll") for (int k = 0; k < 2; ++k) \
        acc[ai][bj][m][n] = __builtin_amdgcn_mfma_f32_16x16x32_bf16(Bt[n][k], At[m][k], acc[ai][bj][m][n], 0, 0, 0); __builtin_amdgcn_s_setprio(0); } while (0)
#define PG8_WAIT_V(n) asm volatile("s_waitcnt vmcnt(" #n ")" ::: "memory")
#define PG8_WAIT_L(n) asm volatile("s_waitcnt lgkmcnt(" #n ")" ::: "memory")
#define PG8_BAR __builtin_amdgcn_s_barrier()
#define PG8_SCHED __builtin_amdgcn_sched_barrier(0)
    Unit cur, nxt; int ui = 0;
    if (!S.next(0, cur)) return;
    f32x4 acc[2][2][4][2];
#pragma unroll
    for (int a = 0; a < 2; ++a)
#pragma unroll
        for (int b = 0; b < 2; ++b)
#pragma unroll
            for (int m = 0; m < 4; ++m)
#pragma unroll
                for (int n = 0; n < 2; ++n) acc[a][b][m][n] = (f32x4){0.f, 0.f, 0.f, 0.f};
    bf16x8 At[4][2], B0[2][2], B1[2][2];
    const char* cA = (const char*)g.A + (size_t)cur.pm * tstep; const char* cB = (const char*)g.Bt + (size_t)cur.pn * tstep;
    S.a_ready(cur);
    if constexpr (SP2) {
        PG8_STAGE(PG8_SB(0, 0), cB, voffB); PG8_STAGE(PG8_SB(0, 1), cB + hstep, voffB); PG8_STAGE(PG8_SA(0, 0), cA, voffA); PG8_STAGE(PG8_SA(0, 1), cA + hstep, voffA);
        if (wr == 1) PG8_BAR;
        PG8_WAIT_V(2); PG8_BAR;
        PG8_STAGE(PG8_SB(1, 0), cB + kstep, voffB); PG8_STAGE(PG8_SA(1, 0), cA + kstep, voffA); PG8_STAGE(PG8_SB(1, 1), cB + hstep + kstep, voffB);
        PG8_WAIT_V(6); PG8_BAR;
    } else {
        PG8_STAGE(PG8_SB(0, 0), cB, voffB); PG8_STAGE(PG8_SA(0, 0), cA, voffA); PG8_STAGE(PG8_SB(0, 1), cB + hstep, voffB); PG8_STAGE(PG8_SA(0, 1), cA + hstep, voffA);
        if (wr == 1) PG8_BAR;
        PG8_WAIT_V(4); PG8_BAR;
        PG8_STAGE(PG8_SB(1, 0), cB + kstep, voffB); PG8_STAGE(PG8_SA(1, 0), cA + kstep, voffA); PG8_STAGE(PG8_SB(1, 1), cB + hstep + kstep, voffB);
        PG8_WAIT_V(6); PG8_BAR;
    }
    for (;;) {
        const bool has_next = S.next(ui + 1, nxt);
        const char* nA = has_next ? (const char*)g.A + (size_t)nxt.pm * tstep : cA; const char* nB = has_next ? (const char*)g.Bt + (size_t)nxt.pn * tstep : cB;
        for (int t = 0; t < nt; t += 2) {
            const bool last = (t == nt - 2);
            const char* a1 = cA + (size_t)(t + 1) * kstep;
            const char* a2 = last ? nA : cA + (size_t)(t + 2) * kstep; const char* b2 = last ? nB : cB + (size_t)(t + 2) * kstep;
            const char* a3 = a2 + kstep; const char* b3 = b2 + kstep;
            if (last && has_next) S.a_ready(nxt);
            if constexpr (SP2) {
            PG8_LDB(B0, 0, 0); PG8_LDB(B1, 0, 1); PG8_SCHED; PG8_LDA(At, 0, 0); PG8_STAGE(PG8_SA(1, 1), a1 + hstep, voffA);
            PG8_WAIT_V(8); PG8_WAIT_L(0); PG8_BAR; PG8_MMA(0, 0, At, B0); PG8_MMA(0, 1, At, B1); PG8_BAR; PG8_SCHED;
            PG8_LDA(At, 0, 1); PG8_STAGE(PG8_SB(0, 0), b2, voffB); PG8_STAGE(PG8_SB(0, 1), b2 + hstep, voffB); PG8_STAGE(PG8_SA(0, 0), a2, voffA);
            PG8_WAIT_V(8); PG8_WAIT_L(0); PG8_BAR; PG8_MMA(1, 0, At, B0); PG8_MMA(1, 1, At, B1); PG8_BAR; PG8_SCHED;
            PG8_LDB(B0, 1, 0); PG8_LDB(B1, 1, 1); PG8_SCHED; PG8_LDA(At, 1, 0); PG8_STAGE(PG8_SA(0, 1), a2 + hstep, voffA);
            PG8_WAIT_V(8); PG8_WAIT_L(0); PG8_BAR; PG8_MMA(0, 0, At, B0); PG8_MMA(0, 1, At, B1); PG8_BAR; PG8_SCHED;
            PG8_LDA(At, 1, 1); PG8_STAGE(PG8_SB(1, 0), b3, voffB); PG8_STAGE(PG8_SB(1, 1), b3 + hstep, voffB); PG8_STAGE(PG8_SA(1, 0), a3, voffA);
            PG8_WAIT_V(8); PG8_WAIT_L(0); PG8_BAR; PG8_MMA(1, 0, At, B0); PG8_MMA(1, 1, At, B1); PG8_BAR; PG8_SCHED;
            } else {
            PG8_LDB(B0, 0, 0); PG8_SCHED; PG8_LDA(At, 0, 0); PG8_STAGE(PG8_SA(1, 1), a1 + hstep, voffA);
            PG8_WAIT_L(8); PG8_BAR; PG8_WAIT_L(0); PG8_MMA(0, 0, At, B0); PG8_BAR; PG8_SCHED;
            PG8_LDB(B1, 0, 1); PG8_STAGE(PG8_SB(0, 0), b2, voffB);
            PG8_BAR; PG8_WAIT_L(0); PG8_MMA(0, 1, At, B1); PG8_BAR;
            PG8_LDA(At, 0, 1); PG8_STAGE(PG8_SA(0, 0), a2, voffA);
            PG8_BAR; PG8_WAIT_L(0); PG8_MMA(1, 0, At, B0); PG8_BAR; PG8_SCHED;
            PG8_STAGE(PG8_SB(0, 1), b2 + hstep, voffB);
            PG8_WAIT_V(6); PG8_BAR; PG8_MMA(1, 1, At, B1); PG8_BAR;
            PG8_LDB(B0, 1, 0); PG8_SCHED; PG8_LDA(At, 1, 0); PG8_STAGE(PG8_SA(0, 1), a2 + hstep, voffA);
            PG8_WAIT_L(8); PG8_BAR; PG8_WAIT_L(0); PG8_MMA(0, 0, At, B0); PG8_BAR; PG8_SCHED;
            PG8_LDB(B1, 1, 1); PG8_STAGE(PG8_SB(1, 0), b3, voffB);
            PG8_BAR; PG8_WAIT_L(0); PG8_MMA(0, 1, At, B1); PG8_BAR;
            PG8_LDA(At, 1, 1); PG8_STAGE(PG8_SA(1, 0), a3, voffA);
            PG8_BAR; PG8_WAIT_L(0); PG8_MMA(1, 0, At, B0); PG8_BAR; PG8_SCHED;
            PG8_STAGE(PG8_SB(1, 1), b3 + hstep, voffB);
            PG8_WAIT_V(6); PG8_BAR; PG8_MMA(1, 1, At, B1); PG8_BAR;
            }
        }
        if constexpr (ALIGN_EPI) { if (wr == 0) PG8_BAR; }
        if constexpr (!Epi::AFTER_DRAIN) { E(acc, cur, wr, wc, fr, fq); S.done(cur); }
        if (!has_next) break;
#pragma unroll
        for (int a = 0; a < 2; ++a)
#pragma unroll
            for (int b = 0; b < 2; ++b)
#pragma unroll
                for (int m = 0; m < 4; ++m)
#pragma unroll
                    for (int n = 0; n < 2; ++n) acc[a][b][m][n] = (f32x4){0.f, 0.f, 0.f, 0.f};
        cur = nxt; cA = nA; cB = nB; ++ui;
        if constexpr (ALIGN_EPI) { if (wr == 1) PG8_BAR; }
    }
    PG8_WAIT_V(0);
    if constexpr (!ALIGN_EPI) { if (wr == 0) PG8_BAR; }
    PG8_BAR;
    if constexpr (Epi::AFTER_DRAIN) { E.fused(acc, cur, wr, wc, fr, fq, lds, wid, lane); S.done(cur); }
#undef PG8_SA
#undef PG8_SB
#undef PG8_STAGE
#undef PG8_LDA
#undef PG8_LDB
#undef PG8_MMA
#undef PG8_WAIT_V
#undef PG8_WAIT_L
#undef PG8_BAR
#undef PG8_SCHED
}
}
using pg8::bf16_t; using pg8::bf16x8; using pg8::f32x4; using pg8::u32x4; using pg8::Unit;
typedef float f32x16 __attribute__((ext_vector_type(16)));
typedef float f32x2 __attribute__((ext_vector_type(2)));
typedef unsigned u32x2 __attribute__((ext_vector_type(2)));
typedef __bf16 bf16x2v __attribute__((ext_vector_type(2)));
#define DI __device__ __forceinline__
#define LAS __attribute__((address_space(3)))
#define LDS_WAIT() asm volatile("s_waitcnt lgkmcnt(0)" ::: "memory")
#define MFMA32(a, b, c) __builtin_amdgcn_mfma_f32_32x32x16_bf16((a), (b), (c), 0, 0, 0)

#define XB_TMO      128
#define XB_XCNT(j)  (256  + 64 * (j))
#define XB_XSUB(j)  (1280 + 64 * (j))
#define XB_XGEN(j)  (2304 + 64 * (j))
#define XB_TOP      3328
#define XB_TOPGEN   3392
#define XCD_BAR_WORDS 3456
#define XB_SPIN_CAP (1u << 18)

__device__ __forceinline__ unsigned xb_ld(unsigned* p)              { return __hip_atomic_load(p, __ATOMIC_RELAXED, __HIP_MEMORY_SCOPE_AGENT); }
__device__ __forceinline__ unsigned xb_add(unsigned* p, unsigned v) { return __hip_atomic_fetch_add(p, v, __ATOMIC_RELAXED, __HIP_MEMORY_SCOPE_AGENT); }
__device__ __forceinline__ unsigned xb_xcc_id() { return (unsigned)__builtin_amdgcn_s_getreg((3 << 11) | 20) & 0xFu; }
#define XB_SPIN(cond, bar) do { unsigned _sp = 0; while (cond) { __builtin_amdgcn_s_sleep(1); \
    if ((++_sp & 255u) == 0u) { if (xb_ld(&(bar)[XB_TMO])) break; if (_sp > XB_SPIN_CAP) { atomicAdd(&(bar)[XB_TMO], 1u); break; } } } } while (0)

struct XcdBarrier {
    unsigned* bar; unsigned x;
    volatile LAS unsigned* st;
};

__device__ __forceinline__ XcdBarrier xcd_barrier_post(unsigned* bar, volatile LAS unsigned* st) {
    XcdBarrier b; b.bar = bar; b.x = xb_xcc_id(); b.st = st;
    if (threadIdx.x == 0) (void)xb_add(&bar[XB_XCNT(b.x)], 1u);
    return b;
}
__device__ __forceinline__ void xcd_barrier_complete(unsigned* bar, unsigned x, unsigned& nloc, unsigned& nx) {
    const unsigned G = gridDim.x * gridDim.y * gridDim.z;
    unsigned sum, cnt, mine, sp = 0u;
    for (;;) {
        sum = 0u; cnt = 0u; mine = 0u;
#pragma unroll
        for (unsigned j = 0; j < 16; ++j) { const unsigned c = xb_ld(&bar[XB_XCNT(j)]); sum += c; cnt += (c > 0u) ? 1u : 0u; mine = (j == x) ? c : mine; }
        if (sum == G) break;
        __builtin_amdgcn_s_sleep(1);
        if ((++sp & 255u) == 0u) { if (xb_ld(&bar[XB_TMO])) break; if (sp > XB_SPIN_CAP) { atomicAdd(&bar[XB_TMO], 1u); break; } }
    }
    nloc = mine > 0u ? mine : 1u; nx = cnt > 0u ? cnt : 1u;
}

__device__ __forceinline__ void xcd_barrier(const XcdBarrier& b) {
    asm volatile("s_waitcnt vmcnt(0)" ::: "memory");
    __syncthreads();
    if (threadIdx.x == 0) {
        unsigned* bar = b.bar;
        __builtin_amdgcn_s_waitcnt(0);
        unsigned nloc = b.st[0], nx = b.st[1];
        if (nloc == 0u) { xcd_barrier_complete(bar, b.x, nloc, nx); b.st[0] = nloc; b.st[1] = nx; }
        const unsigned old = xb_add(&bar[XB_XSUB(b.x)], 1u);
        const unsigned gen = old / nloc;
        if (old + 1u == (gen + 1u) * nloc) {
            __builtin_amdgcn_fence(__ATOMIC_RELEASE, "agent");
            asm volatile("s_waitcnt vmcnt(0)" ::: "memory");
            const unsigned og = xb_add(&bar[XB_TOP], 1u);
            const unsigned tg = og / nx;
            if (og + 1u == (tg + 1u) * nx) xb_add(&bar[XB_TOPGEN], 1u);
            else XB_SPIN(xb_ld(&bar[XB_TOPGEN]) == tg, bar);
            __builtin_amdgcn_fence(__ATOMIC_ACQUIRE, "agent");
            xb_add(&bar[XB_XGEN(b.x)], 1u);
            asm volatile("s_waitcnt vmcnt(0)" ::: "memory");
        } else {
            XB_SPIN(xb_ld(&bar[XB_XGEN(b.x)]) == gen, bar);
            __builtin_amdgcn_fence(__ATOMIC_ACQUIRE, "agent");
            asm volatile("s_waitcnt vmcnt(0)" ::: "memory");
        }
    }
    __syncthreads();
}


constexpr int D = 1024, TL = 16384, CL = 256, RB = TL + CL, NZ = 7936, ZP = 7712, FF = 4096, NMOD = 6144;
constexpr float EPS = 1e-6f, LOG2E = 1.4426950408889634f;
constexpr int C_DQ = 0, C_DK = 512, C_DV = 1024, C_GQ = 1536, C_GK = 1792, C_GV = 2048, C_GG = 2560, C_NQ = 3072, C_NK = 3584, C_NV = 4096, C_GATE = 4608, C_GA = 7680;
constexpr size_t KiB = 1024, MiB = 1024 * 1024;
constexpr size_t WS_MOD = 0, WS_BIN = 256 * KiB, WS_BF1 = 512 * KiB, WS_DEC = 1 * MiB, WS_RSS = 2 * MiB, WS_XSC = 4 * MiB, WS_W = 6 * MiB;
constexpr size_t WL_ELEMS = 19136512, WL_BYTES = WL_ELEMS * 2;
constexpr size_t OFF_WIN = 0, OFF_BR = (size_t)NZ * D, OFF_OUT = OFF_BR + 3 * 524288, OFF_W1 = OFF_OUT + 1048576, OFF_W2 = OFF_W1 + 4194304;
static_assert(OFF_W2 + 4194304 == WL_ELEMS, "weights");
constexpr size_t WS_BAR = 3 * MiB + 512 * KiB;
constexpr size_t WS_A0 = 79 * MiB;
constexpr size_t WS_Y = WS_A0 + (size_t)RB * D * 2;
constexpr size_t YB = (size_t)RB * 512 * 2;
constexpr size_t WS_Z = 161 * MiB;
constexpr size_t WS_S = 406 * MiB;
constexpr size_t WS_VTD = 471 * MiB;
constexpr size_t WS_VTN = WS_VTD + (size_t)512 * RB * 2;
constexpr size_t WS_END = WS_VTN + (size_t)512 * RB * 2;
static_assert(WS_Y + 3 * YB <= WS_Z && WS_Z + (size_t)RB * ZP * 2 <= WS_S && WS_S + (size_t)8 * 260 * 8192 * 4 <= WS_VTD && WS_END <= 504 * MiB, "ws map");
static_assert(WS_W + 2 * WL_BYTES <= WS_A0 && WS_RSS + (size_t)RB * 16 * 4 <= WS_XSC, "ws map 2");

struct Params { const float* in[25]; float* out; unsigned char* ws; };

DI int lane_id_opq() { return (int)__builtin_amdgcn_mbcnt_hi(~0u, __builtin_amdgcn_mbcnt_lo(~0u, (unsigned)opaque_zero())); }
DI float shx(float v, int k) {
  const int x = __float_as_int(v);
  switch (k) {
    case 1: return __int_as_float(__builtin_amdgcn_ds_swizzle(x, 0x041F));
    case 2: return __int_as_float(__builtin_amdgcn_ds_swizzle(x, 0x081F));
    case 4: return __int_as_float(__builtin_amdgcn_ds_swizzle(x, 0x101F));
    case 8: return __int_as_float(__builtin_amdgcn_ds_swizzle(x, 0x201F));
    case 16: return __int_as_float(__builtin_amdgcn_ds_swizzle(x, 0x401F));
    default: return __int_as_float(__builtin_amdgcn_ds_bpermute((lane_id_opq() ^ k) << 2, x));
  }
}
DI float rdl63(float v) { return __int_as_float(__builtin_amdgcn_readlane(__float_as_int(v), 63)); }
DI float bf2f(unsigned short h) { return __uint_as_float(((unsigned)h) << 16); }
DI unsigned pk2(float lo, float hi) { f32x2 f = {lo, hi}; bf16x2v h = __builtin_convertvector(f, bf16x2v); return __builtin_bit_cast(unsigned, h); }
DI void unpack8(const u32x4 w, float (&v)[8]) {
#pragma unroll
  for (int i = 0; i < 4; ++i) { v[2 * i] = __uint_as_float(w[i] << 16); v[2 * i + 1] = __uint_as_float(w[i] & 0xffff0000u); }
}
DI u32x4 pack8(const float (&v)[8]) { u32x4 w; w.x = pk2(v[0], v[1]); w.y = pk2(v[2], v[3]); w.z = pk2(v[4], v[5]); w.w = pk2(v[6], v[7]); return w; }
DI float wave_sum(float v) {
#pragma unroll
  for (int o = 1; o < 64; o <<= 1) v += shx(v, o);
  return v;
}
DI f32x16 zero16() { f32x16 z;
#pragma unroll
  for (int i = 0; i < 16; ++i) z[i] = 0.f; return z; }
DI bf16x8 pack_frag(const f32x16& x, int s) {
  u32x4 p;
  if (s == 0) { p.x = pk2(x[0], x[1]); p.y = pk2(x[2], x[3]); p.z = pk2(x[4], x[5]); p.w = pk2(x[6], x[7]); }
  else { p.x = pk2(x[8], x[9]); p.y = pk2(x[10], x[11]); p.z = pk2(x[12], x[13]); p.w = pk2(x[14], x[15]); }
  return __builtin_bit_cast(bf16x8, p);
}
DI float sigm(float x) { return __builtin_amdgcn_rcpf(1.f + __builtin_amdgcn_exp2f(-LOG2E * x)); }
DI float row_rstd(const float* rss, int row) { const f32x4* p = (const f32x4*)(rss + (size_t)row * 16); const f32x4 a = (p[0] + p[1]) + (p[2] + p[3]); return rsqrtf(((a.x + a.y) + (a.z + a.w)) * (1.f / 1024.f) + EPS); }

struct EpiZ {
  static constexpr bool PERM = true, AFTER_DRAIN = false;
  bf16_t* Z; const float* rss; const float* bias; int b;
  DI void operator()(const f32x4 (&acc)[2][2][4][2], const Unit& u, int wr, int wc, int fr, int fq) const {
    const int row0 = u.pm * 256 + wr * 64 + fr, mi = (u.pm < 64) ? b : 2, col0 = u.pn * 256 + wc * 32 + 8 * fq;
    const bool gate = (u.pn >= 18) && (u.pn < 30);
    f32x4 bv[2][2];
#pragma unroll
    for (int bj = 0; bj < 2; ++bj)
#pragma unroll
      for (int n = 0; n < 2; ++n) bv[bj][n] = *(const f32x4*)(bias + (size_t)mi * NZ + col0 + bj * 128 + 4 * n);
#pragma unroll
    for (int ai = 0; ai < 2; ++ai)
#pragma unroll
      for (int m = 0; m < 4; ++m) {
        const int row = row0 + ai * 128 + m * 16; const float rs = row_rstd(rss, row); bf16_t* rowp = Z + (size_t)row * ZP + col0;
#pragma unroll
        for (int bj = 0; bj < 2; ++bj) {
          f32x4 v0 = acc[ai][bj][m][0] * rs + bv[bj][0], v1 = acc[ai][bj][m][1] * rs + bv[bj][1];
          if (gate) {
#pragma unroll
            for (int e = 0; e < 4; ++e) { v0[e] = sigm(v0[e]); v1[e] = sigm(v1[e]); }
          }
          u32x4 w; w.x = pk2(v0[0], v0[1]); w.y = pk2(v0[2], v0[3]); w.z = pk2(v1[0], v1[1]); w.w = pk2(v1[2], v1[3]);
          if (col0 + bj * 128 < ZP) *(u32x4*)(rowp + bj * 128) = w;
        }
      }
  }
};
struct EpiF1 {
  static constexpr bool PERM = true, AFTER_DRAIN = false;
  bf16_t* H; const float* rss; const float* bias; int b;
  DI void operator()(const f32x4 (&acc)[2][2][4][2], const Unit& u, int wr, int wc, int fr, int fq) const {
    const int row0 = u.pm * 256 + wr * 64 + fr, mi = (u.pm < 64) ? b : 2, col0 = u.pn * 256 + wc * 32 + 8 * fq;
    f32x4 bv[2][2];
#pragma unroll
    for (int bj = 0; bj < 2; ++bj)
#pragma unroll
      for (int n = 0; n < 2; ++n) bv[bj][n] = *(const f32x4*)(bias + (size_t)mi * FF + col0 + bj * 128 + 4 * n);
#pragma unroll
    for (int ai = 0; ai < 2; ++ai)
#pragma unroll
      for (int m = 0; m < 4; ++m) {
        const int row = row0 + ai * 128 + m * 16; const float rs = row_rstd(rss, row); bf16_t* rowp = H + (size_t)row * FF + col0;
#pragma unroll
        for (int bj = 0; bj < 2; ++bj) {
          f32x4 v0 = acc[ai][bj][m][0] * rs + bv[bj][0], v1 = acc[ai][bj][m][1] * rs + bv[bj][1];
#pragma unroll
          for (int e = 0; e < 4; ++e) { float a = fmaxf(v0[e], 0.f), c = fmaxf(v1[e], 0.f); v0[e] = a * a; v1[e] = c * c; }
          u32x4 w; w.x = pk2(v0[0], v0[1]); w.y = pk2(v0[2], v0[3]); w.z = pk2(v1[0], v1[1]); w.w = pk2(v1[2], v1[3]);
          *(u32x4*)(rowp + bj * 128) = w;
        }
      }
  }
};
struct EpiMerge {
  static constexpr bool PERM = true, AFTER_DRAIN = false;
  const bf16_t* Z; bf16_t* Mb; int step;
  DI void operator()(const f32x4 (&acc)[2][2][4][2], const Unit& u, int wr, int wc, int fr, int fq) const {
    const int row0 = u.pm * 256 + wr * 64 + fr, col0 = u.pn * 256 + wc * 32 + 8 * fq;
#pragma unroll
    for (int bj = 0; bj < 2; ++bj) {
      const int col = col0 + bj * 128;
#pragma unroll
      for (int ai = 0; ai < 2; ++ai) {
        u32x4 gw[4], pw[4];
#pragma unroll
        for (int m = 0; m < 4; ++m) { const int row = row0 + ai * 128 + m * 16;
          gw[m] = *(const u32x4*)(Z + (size_t)row * ZP + C_GATE + step * 1024 + col);
          pw[m] = (step > 0) ? *(const u32x4*)(Mb + (size_t)row * D + col) : (u32x4){0u, 0u, 0u, 0u}; }
#pragma unroll
        for (int m = 0; m < 4; ++m) { const int row = row0 + ai * 128 + m * 16;
          float g[8], v[8], p[8]; unpack8(gw[m], g); unpack8(pw[m], p);
#pragma unroll
          for (int e = 0; e < 4; ++e) { v[e] = g[e] * acc[ai][bj][m][0][e] + p[e]; v[4 + e] = g[4 + e] * acc[ai][bj][m][1][e] + p[4 + e]; }
          *(u32x4*)(Mb + (size_t)row * D + col) = pack8(v); }
      }
    }
  }
};
struct EpiRes {
  static constexpr bool PERM = true, AFTER_DRAIN = false;
  const float* inLat; const float* inCtx; float* outLat; float* outCtx; const float* gv; const float* ng; const float* scn; bf16_t* An; float* rss; int b;
  DI void operator()(const f32x4 (&acc)[2][2][4][2], const Unit& u, int wr, int wc, int fr, int fq) const {
    const int row0 = u.pm * 256 + wr * 64 + fr, mi = (u.pm < 64) ? b : 2, col0 = u.pn * 256 + wc * 32 + 8 * fq;
    const bool lat = u.pm < 64;
    float ssr[2][4];
#pragma unroll
    for (int ai = 0; ai < 2; ++ai)
#pragma unroll
      for (int m = 0; m < 4; ++m) ssr[ai][m] = 0.f;
#pragma unroll
    for (int bj = 0; bj < 2; ++bj) {
      const int col = col0 + bj * 128;
      const f32x4 g0 = *(const f32x4*)(gv + (size_t)mi * NMOD + col), g1 = *(const f32x4*)(gv + (size_t)mi * NMOD + col + 4);
      f32x4 w0 = {0.f, 0.f, 0.f, 0.f}, w1 = {0.f, 0.f, 0.f, 0.f};
      if (An) { w0 = *(const f32x4*)(ng + col) * (*(const f32x4*)(scn + (size_t)mi * NMOD + col) + 1.f); w1 = *(const f32x4*)(ng + col + 4) * (*(const f32x4*)(scn + (size_t)mi * NMOD + col + 4) + 1.f); }
#pragma unroll
      for (int ai = 0; ai < 2; ++ai) {
#pragma unroll
        for (int mp = 0; mp < 2; ++mp) {
          f32x4 xin[2][2];
#pragma unroll
          for (int mm = 0; mm < 2; ++mm) { const int row = row0 + ai * 128 + (2 * mp + mm) * 16;
            const float* ip = lat ? inLat + (size_t)row * D + col : inCtx + (size_t)(row - TL) * D + col;
            xin[mm][0] = *(const f32x4*)ip; xin[mm][1] = *(const f32x4*)(ip + 4); }
#pragma unroll
          for (int mm = 0; mm < 2; ++mm) { const int m = 2 * mp + mm;
            const int row = row0 + ai * 128 + m * 16;
            float* op = lat ? outLat + (size_t)row * D + col : outCtx + (size_t)(row - TL) * D + col;
            const f32x4 y0 = xin[mm][0] + g0 * acc[ai][bj][m][0], y1 = xin[mm][1] + g1 * acc[ai][bj][m][1];
            *(f32x4*)op = y0; *(f32x4*)(op + 4) = y1;
            if (An) {
              ssr[ai][m] += (y0.x * y0.x + y0.y * y0.y) + (y0.z * y0.z + y0.w * y0.w) + (y1.x * y1.x + y1.y * y1.y) + (y1.z * y1.z + y1.w * y1.w);
              const f32x4 a0 = y0 * w0, a1 = y1 * w1; u32x4 w; w.x = pk2(a0.x, a0.y); w.y = pk2(a0.z, a0.w); w.z = pk2(a1.x, a1.y); w.w = pk2(a1.z, a1.w);
              *(u32x4*)(An + (size_t)row * D + col) = w;
            }
          }
        }
      }
    }
    if (An) {
#pragma unroll
      for (int ai = 0; ai < 2; ++ai)
#pragma unroll
        for (int m = 0; m < 4; ++m) { float s = ssr[ai][m]; s += shx(s, 16); s += shx(s, 32);
          if (fq == 0) rss[(size_t)(row0 + ai * 128 + m * 16) * 16 + u.pn * 4 + wc] = s; }
    }
  }
};
DI void phase_mod(const Params& P, LAS unsigned char* lds, int tid) {
  LAS float* sc = (LAS float*)lds; LAS float* red = sc + 3072;
  const float* c = P.in[1]; const float* cctx = P.in[3]; const float* wmod = P.in[4]; const float* bmod = P.in[5];
  float* mod = (float*)(P.ws + WS_MOD);
  for (int i = tid; i < 3072; i += 512) { const float v = (i < 2048) ? c[i] : cctx[i - 2048]; sc[i] = v / (1.f + __expf(-v)); }
  __syncthreads();
  for (int u = blockIdx.x; u < 192; u += gridDim.x) {
    const int l = u / 96, n0 = (u % 96) * 64, cl = tid & 63, ks = tid >> 6;
    const float* W = wmod + (size_t)l * D * NMOD + n0 + cl;
    float a0 = 0.f, a1 = 0.f, a2 = 0.f;
#pragma unroll 8
    for (int k = ks * 128; k < ks * 128 + 128; ++k) { const float w = W[(size_t)k * NMOD]; a0 += sc[k] * w; a1 += sc[1024 + k] * w; a2 += sc[2048 + k] * w; }
    red[tid * 3 + 0] = a0; red[tid * 3 + 1] = a1; red[tid * 3 + 2] = a2;
    __syncthreads();
    if (tid < 192) { const int mi = tid >> 6, c2 = tid & 63; float s = 0.f;
      for (int q = 0; q < 8; ++q) s += red[(q * 64 + c2) * 3 + mi];
      mod[(size_t)(l * 3 + mi) * NMOD + n0 + c2] = s + bmod[l * NMOD + n0 + c2]; }
    __syncthreads();
  }
}
DI void tr_item(const float* W, int K, int N, bf16_t* WT, int dst_row, int k0, int n0, LAS float* scr, int lane) {
#pragma unroll 16
  for (int i = 0; i < 32; ++i) { const int kk = 2 * i + (lane >> 5); scr[kk * 33 + (lane & 31)] = W[(size_t)(k0 + kk) * N + n0 + (lane & 31)]; }
  LDS_WAIT();
  const int c = lane & 7;
#pragma unroll
  for (int j = 0; j < 4; ++j) { const int n = (lane >> 3) + 8 * j; const LAS float* s = scr + (8 * c) * 33 + n;
    u32x4 o; o.x = pk2(s[0 * 33], s[1 * 33]); o.y = pk2(s[2 * 33], s[3 * 33]); o.z = pk2(s[4 * 33], s[5 * 33]); o.w = pk2(s[6 * 33], s[7 * 33]);
    *(u32x4*)(WT + (size_t)(dst_row + n) * K + k0 + 8 * c) = o; }
  LDS_WAIT();
}
DI void phase_convert(const Params& P, LAS unsigned char* lds, int tid) {
  const int lane = tid & 63, wave = tid >> 6, gw = blockIdx.x * 8 + wave, NGW = gridDim.x * 8;
  LAS float* scr = (LAS float*)(lds + 49152 + wave * 8448);
  constexpr int PER = 3856 + 768 + 512 + 2048 + 2048;
  for (int it = gw; it < 2 * PER; it += NGW) {
    const int l = it / PER; int r = it % PER;
    bf16_t* WL = (bf16_t*)(P.ws + WS_W + (size_t)l * WL_BYTES);
    if (r < 3856) { const int kb = r / 241, nb = r % 241, n0 = nb * 32, dst = nb < 96 ? n0 : (nb == 96 ? C_GA : n0 - 32);
      tr_item(P.in[8] + (size_t)l * D * 7712, D, 7712, WL + OFF_WIN, dst, kb * 64, n0, scr, lane); continue; }
    r -= 3856;
    if (r < 768) { const int br = r / 256, rr = r % 256, kb = rr / 32, nb = rr % 32;
      tr_item(P.in[19 + br] + (size_t)l * 512 * D, 512, D, WL + OFF_BR + (size_t)br * 524288, nb * 32, kb * 64, nb * 32, scr, lane); continue; }
    r -= 768;
    if (r < 512) { const int kb = r / 32, nb = r % 32; tr_item(P.in[22] + (size_t)l * D * D, D, D, WL + OFF_OUT, nb * 32, kb * 64, nb * 32, scr, lane); continue; }
    r -= 512;
    if (r < 2048) { const int kb = r / 128, nb = r % 128; tr_item(P.in[23] + (size_t)l * D * FF, D, FF, WL + OFF_W1, nb * 32, kb * 64, nb * 32, scr, lane); continue; }
    r -= 2048;
    { const int kb = r / 32, nb = r % 32; tr_item(P.in[24] + (size_t)l * FF * D, FF, D, WL + OFF_W2, nb * 32, kb * 64, nb * 32, scr, lane); }
  }
  for (int i = blockIdx.x * 512 + tid; i < 2 * 28672; i += gridDim.x * 512) { const int l = i / 28672, q = i % 28672;
    u32x4 z = {0u, 0u, 0u, 0u}; *(u32x4*)((bf16_t*)(P.ws + WS_W + (size_t)l * WL_BYTES) + OFF_WIN + (size_t)7712 * D + (size_t)q * 8) = z; }
}
DI void phase_bias(const Params& P, int tid) {
  const int lane = tid & 63, wave = tid >> 6, gw = blockIdx.x * 8 + wave, NGW = gridDim.x * 8;
  const float* mod = (const float*)(P.ws + WS_MOD);
  for (int it = gw; it < 2 * 11808; it += NGW) {
    const int l = it / 11808; int r = it % 11808;
    const bf16_t* WL = (const bf16_t*)(P.ws + WS_W + (size_t)l * WL_BYTES);
    const bf16_t* wrow; const float* shv; float* dst; int dstride;
    if (r < 7712) { wrow = WL + OFF_WIN + (size_t)r * D; shv = mod + (size_t)l * 3 * NMOD; dst = (float*)(P.ws + WS_BIN) + (size_t)l * 3 * NZ + r; dstride = NZ; }
    else { r -= 7712; wrow = WL + OFF_W1 + (size_t)r * D; shv = mod + (size_t)l * 3 * NMOD + 3072; dst = (float*)(P.ws + WS_BF1) + (size_t)l * 3 * FF + r; dstride = FF; }
    float w[16]; { float t[8]; unpack8(*(const u32x4*)(wrow + 16 * lane), t);
#pragma unroll
      for (int e = 0; e < 8; ++e) w[e] = t[e];
      unpack8(*(const u32x4*)(wrow + 16 * lane + 8), t);
#pragma unroll
      for (int e = 0; e < 8; ++e) w[8 + e] = t[e]; }
#pragma unroll
    for (int mi = 0; mi < 3; ++mi) { const float* sp = shv + (size_t)mi * NMOD + 16 * lane; float s = 0.f;
#pragma unroll
      for (int q = 0; q < 4; ++q) { const f32x4 x = *(const f32x4*)(sp + 4 * q); s += x.x * w[4 * q] + x.y * w[4 * q + 1] + x.z * w[4 * q + 2] + x.w * w[4 * q + 3]; }
      s = wave_sum(s); if (lane == 0) dst[(size_t)mi * dstride] = s; }
  }
}
DI void phase_prep(const Params& P, int b, int tid) {
  const int lane = tid & 63, wave = tid >> 6, gw = blockIdx.x * 8 + wave, NGW = gridDim.x * 8;
  const float* mod = (const float*)(P.ws + WS_MOD); bf16_t* A0 = (bf16_t*)(P.ws + WS_A0); float* rss = (float*)(P.ws + WS_RSS);
  const float* ng = P.in[6];
  for (int r = gw; r < RB; r += NGW) {
    const float* src = r < TL ? P.in[0] + ((size_t)b * TL + r) * D : P.in[2] + ((size_t)b * CL + (r - TL)) * D;
    const int mi = r < TL ? b : 2; const float* scv = mod + (size_t)mi * NMOD + 1024;
    f32x4 v[4]; float ss = 0.f;
#pragma unroll
    for (int j = 0; j < 4; ++j) { v[j] = ((const f32x4*)src)[lane + 64 * j]; ss += (v[j].x * v[j].x + v[j].y * v[j].y) + (v[j].z * v[j].z + v[j].w * v[j].w); }
    ss = wave_sum(ss);
#pragma unroll
    for (int j = 0; j < 4; ++j) { const f32x4 g = ((const f32x4*)ng)[lane + 64 * j], s = ((const f32x4*)scv)[lane + 64 * j]; const f32x4 a = v[j] * g * (s + 1.f);
      u32x2 o; o.x = pk2(a.x, a.y); o.y = pk2(a.z, a.w); *(u32x2*)(A0 + (size_t)r * D + 4 * (lane + 64 * j)) = o; }
    if (lane < 16) rss[(size_t)r * 16 + lane] = lane == 0 ? ss : 0.f;
  }
}
DI void postproc_rows(const Params& P, int l, int tid) {
  const int lane = tid & 63, wave = tid >> 6, gw = blockIdx.x * 8 + wave, NGW = gridDim.x * 8, j = lane & 7;
  bf16_t* Z = (bf16_t*)(P.ws + WS_Z);
  const float* gq = P.in[9] + l * 64; const float* gk = P.in[10] + l * 64; const float* nq = P.in[16] + l * 64; const float* nk = P.in[17] + l * 64;
  u32x4 cur[4], nxt[4];
#pragma unroll
  for (int q = 0; q < 4; ++q) { cur[q] = (u32x4){0u, 0u, 0u, 0u}; nxt[q] = cur[q]; }
  if (gw < RB) {
#pragma unroll
    for (int q = 1; q < 4; q += 2) cur[q] = *(const u32x4*)(Z + (size_t)gw * ZP + (q == 1 ? C_DK : C_NK) + 8 * lane); }
  for (int r = gw; r < RB; r += NGW) {
    if (r + NGW < RB) {
#pragma unroll
      for (int q = 1; q < 4; q += 2) nxt[q] = *(const u32x4*)(Z + (size_t)(r + NGW) * ZP + (q == 1 ? C_DK : C_NK) + 8 * lane); }
    const bool lat = r < TL; float cs[8], sn[8];
    if (lat) { const float pos = (j < 4) ? (float)(r >> 6) : (float)(r & 63);
#pragma unroll
      for (int e = 0; e < 8; ++e) { const int i = 8 * (j & 1) + e; const float freq = __builtin_amdgcn_exp2f(-(float)i * 0.830482023721841f); const float ang = pos * freq;
        const float n = rintf(ang * 0.15915494309189535f); float rr = fmaf(-n, 6.2831855f, ang); rr = fmaf(-n, -1.7484555e-7f, rr); cs[e] = __cosf(rr); sn[e] = __sinf(rr); } }
    else {
#pragma unroll
      for (int e = 0; e < 8; ++e) { cs[e] = 1.f; sn[e] = 0.f; } }
    bf16_t* Zr = Z + (size_t)r * ZP;
#pragma unroll
    for (int pass = 1; pass < 4; pass += 2) {
      const int colbase = pass == 0 ? C_DQ : pass == 1 ? C_DK : pass == 2 ? C_NQ : C_NK;
      const float* g = pass == 0 ? gq : pass == 1 ? gk : pass == 2 ? nq : nk;
      const float scale = (pass == 0 || pass == 2) ? 0.125f * LOG2E : 1.f;
      float v[8]; unpack8(cur[pass], v);
      float ss = 0.f;
#pragma unroll
      for (int e = 0; e < 8; ++e) ss += v[e] * v[e];
      ss += shx(ss, 1); ss += shx(ss, 2); ss += shx(ss, 4);
      const float rstd = rsqrtf(ss * (1.f / 64.f) + EPS) * scale;
      const f32x4 g0 = *(const f32x4*)(g + 8 * j), g1 = *(const f32x4*)(g + 8 * j + 4);
#pragma unroll
      for (int e = 0; e < 4; ++e) { v[e] = v[e] * rstd * g0[e]; v[4 + e] = v[4 + e] * rstd * g1[e]; }
      if (pass < 2 && lat) {
#pragma unroll
        for (int e = 0; e < 8; ++e) { const float p = shx(v[e], 2); v[e] = (j & 2) ? v[e] * cs[e] + p * sn[e] : v[e] * cs[e] - p * sn[e]; } }
      *(u32x4*)(Zr + colbase + 8 * lane) = pack8(v);
    }
#pragma unroll
    for (int q = 0; q < 4; ++q) cur[q] = nxt[q];
  }
}
DI void vt_items(const Params& P, LAS unsigned char* lds, int tid) {
  const int lane = tid & 63, wave = tid >> 6, gw = blockIdx.x * 8 + wave, NGW = gridDim.x * 8;
  const bf16_t* Z = (const bf16_t*)(P.ws + WS_Z);
  LAS bf16_t* scr = (LAS bf16_t*)(lds + wave * 9216);
  for (int it = gw; it < 260 * 16; it += NGW) {
    const int rb = it >> 4, cb = it & 15;
    const int col0 = cb < 8 ? C_DV + 64 * cb : C_NV + 64 * (cb - 8);
    bf16_t* Vt = cb < 8 ? (bf16_t*)(P.ws + WS_VTD) + (size_t)(64 * cb) * RB : (bf16_t*)(P.ws + WS_VTN) + (size_t)(64 * (cb - 8)) * RB;
#pragma unroll
    for (int i = 0; i < 8; ++i) { const int row = 8 * i + (lane >> 3), piece = lane & 7;
      const u32x4 w = *(const u32x4*)(Z + (size_t)(64 * rb + row) * ZP + col0 + 8 * piece);
#pragma unroll
      for (int e = 0; e < 4; ++e) { scr[(8 * piece + 2 * e) * 72 + row] = (bf16_t)(w[e] & 0xffffu); scr[(8 * piece + 2 * e + 1) * 72 + row] = (bf16_t)(w[e] >> 16); } }
    LDS_WAIT();
#pragma unroll
    for (int i = 0; i < 8; ++i) { const int c = 8 * i + (lane >> 3), piece = lane & 7;
      const int t0 = 16 * (piece >> 1) + 4 * (piece & 1);
      const u32x2 lo = *(const LAS u32x2*)(scr + c * 72 + t0), hi = *(const LAS u32x2*)(scr + c * 72 + t0 + 8);
      const u32x4 o = {lo.x, lo.y, hi.x, hi.y};
      *(u32x4*)(Vt + (size_t)c * RB + 64 * rb + 8 * piece) = o; }
    LDS_WAIT();
  }
}
DI void gla_cum8(const Params& P, int l, int h, int dir, const bf16_t* zc, int wave, int lane, float (&cum)[8]) {
  const float* a2 = P.in[13] + ((size_t)(l * 2 + dir) * 16) * 256 + h * 64 + 8 * wave;
  const float* ab = P.in[14] + (size_t)(l * 2 + dir) * 256 + h * 64 + 8 * wave;
  float ga[16];
  { float t[8]; unpack8(*(const u32x4*)(zc + C_GA + dir * 16), t);
#pragma unroll
    for (int e = 0; e < 8; ++e) ga[e] = t[e];
    unpack8(*(const u32x4*)(zc + C_GA + dir * 16 + 8), t);
#pragma unroll
    for (int e = 0; e < 8; ++e) ga[8 + e] = t[e]; }
#pragma unroll
  for (int i = 0; i < 8; ++i) { float z = ab[i];
#pragma unroll
    for (int r = 0; r < 16; ++r) z += ga[r] * a2[r * 256 + i];
    cum[i] = (fminf(z, 0.f) - __logf(1.f + __expf(-fabsf(z)))) * (1.f / 16.f); }
#pragma unroll
  for (int i = 0; i < 8; ++i) { float v = cum[i];
    v += __int_as_float(__builtin_amdgcn_update_dpp(0, __float_as_int(v), 0x111, 0xf, 0xf, false));
    v += __int_as_float(__builtin_amdgcn_update_dpp(0, __float_as_int(v), 0x112, 0xf, 0xf, false));
    v += __int_as_float(__builtin_amdgcn_update_dpp(0, __float_as_int(v), 0x114, 0xf, 0xf, false));
    v += __int_as_float(__builtin_amdgcn_update_dpp(0, __float_as_int(v), 0x118, 0xf, 0xf, false));
    v += __int_as_float(__builtin_amdgcn_update_dpp(0, __float_as_int(v), 0x142, 0xa, 0xf, false));
    v += __int_as_float(__builtin_amdgcn_update_dpp(0, __float_as_int(v), 0x143, 0xc, 0xf, false));
    cum[i] = v; }
}
DI bf16_t bfr(float x) { return (bf16_t)(pk2(x, 0.f) & 0xffffu); }
DI void gla_g1_unit(const Params& P, int l, int u, LAS unsigned char* lds, int tid) {
  const int chain = u / 260, n = u % 260, h = chain >> 1, dir = chain & 1;
  const int rbase = dir == 0 ? (n < 4 ? TL + 64 * n : 64 * (n - 4)) : (n < 4 ? TL + 255 - 64 * n : TL - 1 - 64 * (n - 4));
  const int rstep = dir == 0 ? 1 : -1;
  const int lane = tid & 63, wave = __builtin_amdgcn_readfirstlane(tid >> 6), r = lane & 31, hh = lane >> 5;
  const bf16_t* Z = (const bf16_t*)(P.ws + WS_Z);
  LAS bf16_t* kdT = (LAS bf16_t*)lds; LAS bf16_t* vT = (LAS bf16_t*)(lds + 9216);
  const bf16_t* zc = Z + (size_t)(rbase + rstep * lane) * ZP;
  const u32x4 k8 = *(const u32x4*)(zc + C_GK + h * 64 + 8 * wave);
  const int c2 = tid & 63, piece = tid >> 6;
  const bf16_t* zv = Z + (size_t)(rbase + rstep * c2) * ZP + C_GV + h * 128 + 16 * piece;
  const u32x4 va = *(const u32x4*)zv, vb = *(const u32x4*)(zv + 8);
  float cum[8]; gla_cum8(P, l, h, dir, zc, wave, lane, cum);
  float kf[8]; unpack8(k8, kf);
#pragma unroll
  for (int i = 0; i < 8; ++i) { const float cl = rdl63(cum[i]); kdT[(8 * wave + i) * 72 + lane] = bfr(kf[i] * __expf(cl - cum[i]));
    if (lane == 63) ((float*)(P.ws + WS_DEC))[(size_t)u * 64 + 8 * wave + i] = __expf(cl); }
#pragma unroll
  for (int e = 0; e < 4; ++e) { vT[(16 * piece + 2 * e) * 72 + c2] = (bf16_t)(va[e] & 0xffffu); vT[(16 * piece + 2 * e + 1) * 72 + c2] = (bf16_t)(va[e] >> 16);
    vT[(16 * piece + 8 + 2 * e) * 72 + c2] = (bf16_t)(vb[e] & 0xffffu); vT[(16 * piece + 8 + 2 * e + 1) * 72 + c2] = (bf16_t)(vb[e] >> 16); }
  __syncthreads();
  const int dt = wave >> 2, vt = wave & 3;
  f32x16 acc = zero16();
#pragma unroll
  for (int ks = 0; ks < 4; ++ks) { const bf16x8 a = *(const LAS bf16x8*)(kdT + (32 * dt + r) * 72 + 16 * ks + 8 * hh), bb = *(const LAS bf16x8*)(vT + (32 * vt + r) * 72 + 16 * ks + 8 * hh); acc = MFMA32(a, bb, acc); }
  bf16_t* S = (bf16_t*)(P.ws + WS_S) + (size_t)u * 8192;
#pragma unroll
  for (int i = 0; i < 16; ++i) S[(size_t)(32 * dt + (i & 3) + 8 * (i >> 2) + 4 * hh) * 128 + 32 * vt + r] = bfr(acc[i]);
  __syncthreads();
}
DI void gla_scan(const Params& P, int tid) {
  bf16_t* S = (bf16_t*)(P.ws + WS_S); const float* dec = (const float*)(P.ws + WS_DEC);
  if (tid < 256) for (int gid = blockIdx.x * 256 + tid; gid < 65536; gid += gridDim.x * 256) {
    const int chain = gid >> 13, e = gid & 8191, d = e >> 7;
    bf16_t* Sp = S + (size_t)chain * 260 * 8192 + e; const float* dp = dec + (size_t)chain * 260 * 64 + d; float s = 0.f;
    for (int n0 = 0; n0 < 260; n0 += 10) {
      float ds[10], dc[10];
#pragma unroll
      for (int i = 0; i < 10; ++i) { ds[i] = bf2f(Sp[(size_t)(n0 + i) * 8192]); dc[i] = dp[(n0 + i) * 64]; }
#pragma unroll
      for (int i = 0; i < 10; ++i) { const float prev = s; s = dc[i] * s + ds[i]; ds[i] = prev; }
#pragma unroll
      for (int i = 0; i < 10; ++i) Sp[(size_t)(n0 + i) * 8192] = bfr(ds[i]);
    }
  }
}
DI void gla_g3_unit(const Params& P, int l, int u, LAS unsigned char* lds, int tid) {
  const int h = u / 260, m = u % 260, base = m < 256 ? 64 * m : TL + 64 * (m - 256);
  const int lane = tid & 63, wave = __builtin_amdgcn_readfirstlane(tid >> 6), r = lane & 31, hh = lane >> 5;
  const bf16_t* Z = (const bf16_t*)(P.ws + WS_Z);
  LAS bf16_t* qeL = (LAS bf16_t*)lds; LAS bf16_t* keL = (LAS bf16_t*)(lds + 9216); LAS bf16_t* vT = (LAS bf16_t*)(lds + 18432); LAS bf16_t* ST = (LAS bf16_t*)(lds + 36864);
  LAS float* oL = (LAS float*)(lds + 55296);
  const int c2 = tid >> 3, piece = tid & 7;
  const int cs2 = tid & 63, ps2 = tid >> 6;
  const int pos2 = (cs2 & ~15) | (cs2 & 3) | ((cs2 & 4) << 1) | ((cs2 & 8) >> 1);
  for (int dir = 0; dir < 2; ++dir) {
    const int n = dir == 0 ? (m < 256 ? m + 4 : m - 256) : (m < 256 ? 259 - m : 3 - (m - 256));
    const int rbase = dir == 0 ? base : base + 63, rstep = dir == 0 ? 1 : -1;
    const bf16_t* zc = Z + (size_t)(rbase + rstep * lane) * ZP;
    const u32x4 q8 = *(const u32x4*)(zc + C_GQ + h * 64 + 8 * wave), k8 = *(const u32x4*)(zc + C_GK + h * 64 + 8 * wave);
    const bf16_t* zv = Z + (size_t)(rbase + rstep * cs2) * ZP + C_GV + h * 128 + 16 * ps2;
    const u32x4 va = *(const u32x4*)zv, vb = *(const u32x4*)(zv + 8);
    const bf16_t* Sn = (const bf16_t*)(P.ws + WS_S) + (size_t)((h * 2 + dir) * 260 + n) * 8192 + (size_t)cs2 * 128 + 16 * ps2;
    const u32x4 sa = *(const u32x4*)Sn, sbv = *(const u32x4*)(Sn + 8);
    float cum[8]; gla_cum8(P, l, h, dir, zc, wave, lane, cum);
    { float qf[8], kf[8]; unpack8(q8, qf); unpack8(k8, kf);
#pragma unroll
      for (int i = 0; i < 8; ++i) { const float e = __expf(cum[i]); qf[i] = qf[i] * 0.125f * e; kf[i] = kf[i] * __builtin_amdgcn_rcpf(e); }
      *(LAS u32x4*)(qeL + lane * 72 + 8 * wave) = pack8(qf); *(LAS u32x4*)(keL + lane * 72 + 8 * wave) = pack8(kf); }
#pragma unroll
    for (int e = 0; e < 4; ++e) { vT[(16 * ps2 + 2 * e) * 72 + pos2] = (bf16_t)(va[e] & 0xffffu); vT[(16 * ps2 + 2 * e + 1) * 72 + pos2] = (bf16_t)(va[e] >> 16);
      vT[(16 * ps2 + 8 + 2 * e) * 72 + pos2] = (bf16_t)(vb[e] & 0xffffu); vT[(16 * ps2 + 8 + 2 * e + 1) * 72 + pos2] = (bf16_t)(vb[e] >> 16); }
#pragma unroll
    for (int e = 0; e < 4; ++e) { ST[(16 * ps2 + 2 * e) * 72 + cs2] = (bf16_t)(sa[e] & 0xffffu); ST[(16 * ps2 + 2 * e + 1) * 72 + cs2] = (bf16_t)(sa[e] >> 16);
      ST[(16 * ps2 + 8 + 2 * e) * 72 + cs2] = (bf16_t)(sbv[e] & 0xffffu); ST[(16 * ps2 + 8 + 2 * e + 1) * 72 + cs2] = (bf16_t)(sbv[e] >> 16); }
    __syncthreads();
    const int vt = wave >> 1, ct = wave & 1;
    f32x16 o = zero16();
#pragma unroll
    for (int st = 0; st < 2; ++st) {
      if (st > ct) continue;
      f32x16 x = zero16();
#pragma unroll
      for (int ks = 0; ks < 4; ++ks) { const bf16x8 a = *(const LAS bf16x8*)(keL + (32 * st + r) * 72 + 16 * ks + 8 * hh), bb = *(const LAS bf16x8*)(qeL + (32 * ct + r) * 72 + 16 * ks + 8 * hh); x = MFMA32(a, bb, x); }
      if (st == ct) {
#pragma unroll
        for (int i = 0; i < 16; ++i) if (((i & 3) + 8 * (i >> 2) + 4 * hh) > r) x[i] = 0.f; }
#pragma unroll
      for (int sk = 0; sk < 2; ++sk) { const bf16x8 pb = pack_frag(x, sk); const bf16x8 a = *(const LAS bf16x8*)(vT + (32 * vt + r) * 72 + 32 * st + 16 * sk + 8 * hh); o = MFMA32(a, pb, o); }
    }
#pragma unroll
    for (int ks = 0; ks < 4; ++ks) { const bf16x8 a = *(const LAS bf16x8*)(ST + (32 * vt + r) * 72 + 16 * ks + 8 * hh), bb = *(const LAS bf16x8*)(qeL + (32 * ct + r) * 72 + 16 * ks + 8 * hh); o = MFMA32(a, bb, o); }
    { const int c = 32 * ct + r, lr = dir ? 63 - c : c;
#pragma unroll
      for (int g = 0; g < 4; ++g) { LAS f32x4* p = (LAS f32x4*)(oL + lr * 132 + 32 * vt + 8 * g + 4 * hh); const f32x4 val = {o[4 * g], o[4 * g + 1], o[4 * g + 2], o[4 * g + 3]};
        if (dir == 0) *p = val; else *p = *p + val; } }
    __syncthreads();
  }
  { const int row = base + c2; const float* gn = P.in[15] + l * 128 + 16 * piece; bf16_t* Yg = (bf16_t*)(P.ws + WS_Y + YB);
    const LAS f32x4* op = (const LAS f32x4*)(oL + c2 * 132 + 16 * piece);
    f32x4 ov[4]; float ss = 0.f;
#pragma unroll
    for (int q = 0; q < 4; ++q) { ov[q] = op[q]; ss += (ov[q].x * ov[q].x + ov[q].y * ov[q].y) + (ov[q].z * ov[q].z + ov[q].w * ov[q].w); }
    ss += shx(ss, 1); ss += shx(ss, 2); ss += shx(ss, 4);
    const float rstd = rsqrtf(ss * (1.f / 128.f) + EPS);
    float g[16]; { float t[8]; const bf16_t* gp = Z + (size_t)row * ZP + C_GG + h * 128 + 16 * piece; unpack8(*(const u32x4*)gp, t);
#pragma unroll
      for (int e = 0; e < 8; ++e) g[e] = t[e];
      unpack8(*(const u32x4*)(gp + 8), t);
#pragma unroll
      for (int e = 0; e < 8; ++e) g[8 + e] = t[e]; }
    float y[16];
#pragma unroll
    for (int q = 0; q < 4; ++q) { const f32x4 gv = *(const f32x4*)(gn + 4 * q);
#pragma unroll
      for (int e = 0; e < 4; ++e) { const float gg = g[4 * q + e]; y[4 * q + e] = ov[q][e] * rstd * gv[e] * gg * sigm(gg); } }
    float y0[8], y1[8];
#pragma unroll
    for (int e = 0; e < 8; ++e) { y0[e] = y[e]; y1[e] = y[8 + e]; }
    bf16_t* yp = Yg + (size_t)row * 512 + h * 128 + 16 * piece; *(u32x4*)yp = pack8(y0); *(u32x4*)(yp + 8) = pack8(y1); }
}
DI void q_norm_rope(const u32x4 (&raw)[4], const float* g, float scale, bool rope, int token, int hh, bf16x8 (&out)[4]) {
  float v[4][8]; float ss = 0.f;
#pragma unroll
  for (int ks = 0; ks < 4; ++ks) { unpack8(raw[ks], v[ks]);
#pragma unroll
    for (int j = 0; j < 8; ++j) ss += v[ks][j] * v[ks][j]; }
  ss += shx(ss, 32);
  const float rstd = rsqrtf(ss * (1.f / 64.f) + EPS) * scale;
#pragma unroll
  for (int ks = 0; ks < 4; ++ks) { const f32x4 g0 = *(const f32x4*)(g + 16 * ks + 8 * hh), g1 = *(const f32x4*)(g + 16 * ks + 8 * hh + 4);
#pragma unroll
    for (int j = 0; j < 4; ++j) { v[ks][j] *= rstd * g0[j]; v[ks][4 + j] *= rstd * g1[j]; } }
  if (rope) { const float prow = (float)(token >> 6), pcol = (float)(token & 63);
#pragma unroll
    for (int j = 0; j < 8; ++j) { const float freq = __builtin_amdgcn_exp2f(-(float)(8 * hh + j) * 0.830482023721841f);
#pragma unroll
      for (int half = 0; half < 2; ++half) { const float ang = (half ? pcol : prow) * freq;
        const float n = rintf(ang * 0.15915494309189535f); float rr = fmaf(-n, 6.2831855f, ang); rr = fmaf(-n, -1.7484555e-7f, rr); const float c = __cosf(rr), sn = __sinf(rr);
        const float x1 = v[2 * half][j], x2 = v[2 * half + 1][j]; v[2 * half][j] = x1 * c - x2 * sn; v[2 * half + 1][j] = x1 * sn + x2 * c; } } }
#pragma unroll
  for (int ks = 0; ks < 4; ++ks) out[ks] = __builtin_bit_cast(bf16x8, pack8(v[ks]));
}
constexpr int NA_TAB_BYTES = 15392, NA_STAGE_BYTES = 65536, NA_VOFF = 32768;
DI void na_issue_tile(const bf16_t* Z, const bf16_t* Vt, int hg, int key0, LAS unsigned char* stage, int wave, int lane) {
#pragma unroll
  for (int i = 0; i < 4; ++i) { const int blk = 4 * wave + i, row = 2 * blk + (lane >> 5), slot = lane & 31, piece = (slot & 16) | ((slot & 15) ^ (row & 15));
    const bf16_t* g = Z + (size_t)(key0 + row) * ZP + C_NK + hg * 256 + piece * 8;
    __builtin_amdgcn_global_load_lds((const unsigned*)g, (LAS unsigned*)(stage + blk * 1024), 16, 0, 0); }
#pragma unroll
  for (int i = 0; i < 4; ++i) { const int blk = 4 * wave + i, row = 8 * blk + (lane >> 3), piece = (lane & 7) ^ ((row >> 1) & 7);
    const bf16_t* g = Vt + (size_t)(hg * 256 + row) * RB + key0 + piece * 8;
    __builtin_amdgcn_global_load_lds((const unsigned*)g, (LAS unsigned*)(stage + NA_VOFF + blk * 1024), 16, 0, 0); }
}
DI void na_block_unit(const Params& P, int l, int bu, LAS unsigned char* lds, int tid) {
  const int lane = tid & 63, wave = __builtin_amdgcn_readfirstlane(tid >> 6), r = lane & 31, hh = lane >> 5, hl = wave >> 1, qh = wave & 1;
  const bf16_t* Z = (const bf16_t*)(P.ws + WS_Z); const bf16_t* Vt = (const bf16_t*)(P.ws + WS_VTN); bf16_t* Yn = (bf16_t*)(P.ws + WS_Y + 2 * YB);
  const LAS float* rpbL = (const LAS float*)lds;
  int hg, gr, qrow0, nt; bool latq;
  if (bu < 512) { hg = bu & 1; gr = bu >> 1; qrow0 = gr * 64; nt = 12; latq = true; } else { const int uu = bu - 512; hg = uu & 1; gr = 0; qrow0 = TL + 64 * (uu >> 1); nt = 4; latq = false; }
  const int h = 4 * hg + hl, w = 32 * qh + r, qrow = qrow0 + w;
  const int rs = min(max(gr - 4, 0), 248), cs = min(max(w - 8, 0), 48);
  const int lanec = 15 - w + 4 * hh, csl = cs - 4 * hh;
  LAS unsigned char* st0 = lds + NA_TAB_BYTES;
  na_issue_tile(Z, Vt, hg, latq ? rs * 64 : TL, st0, wave, lane);
  bf16x8 bq[4]; u32x4 braw[4];
#pragma unroll
  for (int ks = 0; ks < 4; ++ks) braw[ks] = *(const u32x4*)(Z + (size_t)qrow * ZP + C_NQ + h * 64 + 16 * ks + 8 * hh);
  q_norm_rope(braw, P.in[16] + l * 64, 0.125f * LOG2E, false, 0, hh, bq);
  const int mk = r & 15, mv = (r >> 1) & 7;
  const int kfr = r * 512 + (hl >> 1) * 256, vfr = NA_VOFF + (hl * 64 + r) * 128;
  f32x16 o[2]; o[0] = zero16(); o[1] = zero16(); float lsum = 0.f;
  asm volatile("s_waitcnt vmcnt(0)" ::: "memory");
  __syncthreads();
  for (int ti = 0; ti < nt; ++ti) {
    const int cur = ti & 1; const bool band = latq && ti < 8;
    if (ti + 1 < nt) { const int tn = ti + 1; const int keyn = (latq && tn < 8) ? (rs + tn) * 64 : TL + 64 * (latq ? tn - 8 : tn);
      na_issue_tile(Z, Vt, hg, keyn, st0 + (cur ^ 1) * NA_STAGE_BYTES, wave, lane); }
    const LAS unsigned char* sb = st0 + cur * NA_STAGE_BYTES;
    const int relrow = rs + ti - gr + 7;
    const LAS float* tb = rpbL + 64 + (h * 15 + (band ? relrow : 0)) * 31 + lanec;
#pragma unroll
    for (int st = 0; st < 2; ++st) {
      f32x16 s = zero16();
#pragma unroll
      for (int ks = 0; ks < 4; ++ks) { const bf16x8 a = *(const LAS bf16x8*)(sb + kfr + st * (32 * 512) + (((8 * (hl & 1) + 2 * ks + hh) ^ mk) << 4)); s = MFMA32(a, bq[ks], s); }
      if (band) {
        const bool few = (st == 1) ? (qh == 0) : (qh == 1);
        if (few) {
#pragma unroll
          for (int i = 0; i < 16; ++i) { const int c = 32 * st + (i & 3) + 8 * (i >> 2); const bool live = (st == 1) ? ((i >> 2) == 0) : ((i >> 2) == 3);
            if (live) { const float e = __builtin_amdgcn_exp2f(s[i] + tb[c]); const float p = ((unsigned)(c - csl) < 16u) ? e : 0.f; lsum += p; s[i] = p; } else s[i] = 0.f; }
        } else {
#pragma unroll
          for (int i = 0; i < 16; ++i) { const int c = 32 * st + (i & 3) + 8 * (i >> 2);
            const float e = __builtin_amdgcn_exp2f(s[i] + tb[c]); const float p = ((unsigned)(c - csl) < 16u) ? e : 0.f; lsum += p; s[i] = p; }
        }
      } else {
#pragma unroll
        for (int i = 0; i < 16; ++i) { const float p = __builtin_amdgcn_exp2f(s[i]); lsum += p; s[i] = p; }
      }
#pragma unroll
      for (int s2 = 0; s2 < 2; ++s2) { const bf16x8 pb = pack_frag(s, s2);
#pragma unroll
        for (int dvt = 0; dvt < 2; ++dvt) { const bf16x8 a = *(const LAS bf16x8*)(sb + vfr + dvt * (32 * 128) + (((4 * st + 2 * s2 + hh) ^ mv) << 4)); o[dvt] = MFMA32(a, pb, o[dvt]); } }
    }
    asm volatile("s_waitcnt vmcnt(0)" ::: "memory");
    __syncthreads();
  }
  lsum += shx(lsum, 32);
  const float inv = 1.f / lsum;
#pragma unroll
  for (int dvt = 0; dvt < 2; ++dvt)
#pragma unroll
    for (int g = 0; g < 4; ++g) { u32x2 wv; wv.x = pk2(o[dvt][4 * g] * inv, o[dvt][4 * g + 1] * inv); wv.y = pk2(o[dvt][4 * g + 2] * inv, o[dvt][4 * g + 3] * inv);
      *(u32x2*)(Yn + (size_t)qrow * 512 + h * 64 + 32 * dvt + 8 * g + 4 * hh) = wv; }
}
constexpr int DA_STAGE0 = 65536, DA_STAGE_BYTES = 32768, DA_VOFF = 16384;
DI void da_issue_tile(const bf16_t* Z, const bf16_t* Vt, int h, int key0, LAS unsigned char* stage, int wave, int lane) {
#pragma unroll
  for (int i = 0; i < 2; ++i) { const int row = 4 * (2 * wave + i) + (lane >> 4), piece = (lane & 15) ^ (row & 15);
    const bf16_t* g = Z + (size_t)(key0 + row) * ZP + C_DK + h * 128 + piece * 8;
    __builtin_amdgcn_global_load_lds((const unsigned*)g, (LAS unsigned*)(stage + (2 * wave + i) * 1024), 16, 0, 0); }
#pragma unroll
  for (int i = 0; i < 2; ++i) { const int row = 8 * (2 * wave + i) + (lane >> 3), piece = (lane & 7) ^ ((row >> 1) & 7);
    const bf16_t* g = Vt + (size_t)(h * 128 + row) * RB + key0 + piece * 8;
    __builtin_amdgcn_global_load_lds((const unsigned*)g, (LAS unsigned*)(stage + DA_VOFF + (2 * wave + i) * 1024), 16, 0, 0); }
}
DI void da_unit(const Params& P, int l, int u, float lam, float lam_init, LAS unsigned char* lds, int tid) {
  const int lane = tid & 63, wave = __builtin_amdgcn_readfirstlane(tid >> 6), r = lane & 31, hh = lane >> 5, pr = wave >> 1, sidx = wave & 1;
  const bf16_t* Z = (const bf16_t*)(P.ws + WS_Z); const bf16_t* Vt = (const bf16_t*)(P.ws + WS_VTD); bf16_t* Yd = (bf16_t*)(P.ws + WS_Y);
  int h, q0, t0, t1;
  if (u < 256) { h = u & 3; q0 = (u >> 2) * 256; t0 = 0; t1 = 260; } else { h = u - 256; q0 = TL; t0 = 256; t1 = 260; }
  const int qrow = q0 + 64 * pr + r;
  da_issue_tile(Z, Vt, h, 64 * t0, lds + DA_STAGE0, wave, lane);
  bf16x8 qA[4]; u32x4 rawA[4], rawB[4];
  LAS bf16x8* qL = (LAS bf16x8*)(lds + wave * 4096) + lane;
#pragma unroll
  for (int ks = 0; ks < 4; ++ks) { const bf16_t* qp = Z + (size_t)qrow * ZP + C_DQ + h * 128 + 64 * sidx + 16 * ks + 8 * hh; rawA[ks] = *(const u32x4*)qp; rawB[ks] = *(const u32x4*)(qp + (size_t)32 * ZP); }
  { const float* gq = P.in[9] + l * 64; const bool lat = u < 256; bf16x8 qB[4];
    q_norm_rope(rawA, gq, 0.125f * LOG2E, lat, qrow, hh, qA); q_norm_rope(rawB, gq, 0.125f * LOG2E, lat, qrow + 32, hh, qB);
#pragma unroll
    for (int ks = 0; ks < 4; ++ks) qL[ks * 64] = qB[ks]; }
  const int mk = r & 15, mv = (r >> 1) & 7;
  const int kfr = r * 256, vfr = DA_VOFF + r * 128;
  asm volatile("s_waitcnt vmcnt(0)" ::: "memory");
  __syncthreads();
  f32x16 oA[4], oB[4];
#pragma unroll
  for (int i = 0; i < 4; ++i) { oA[i] = zero16(); oB[i] = zero16(); }
  float lA = 0.f, lB = 0.f;
  for (int t = t0; t < t1; ++t) {
    const int cur = (t - t0) & 1;
    if (t + 1 < t1) da_issue_tile(Z, Vt, h, 64 * (t + 1), lds + DA_STAGE0 + (cur ^ 1) * DA_STAGE_BYTES, wave, lane);
    const LAS unsigned char* sb = lds + DA_STAGE0 + cur * DA_STAGE_BYTES;
#pragma unroll 2
    for (int st = 0; st < 2; ++st) {
      bf16x8 pA[2], pB[2];
      const LAS unsigned char* kf = sb + kfr + st * (32 * 256);
      { f32x16 sA = zero16(), sB = zero16();
#pragma unroll
        for (int ks = 0; ks < 4; ++ks) { const bf16x8 a = *(const LAS bf16x8*)(kf + (((8 * sidx + 2 * ks + hh) ^ mk) << 4)); sA = MFMA32(a, qA[ks], sA); sB = MFMA32(a, qL[ks * 64], sB); }
#pragma unroll
        for (int i = 0; i < 16; ++i) { sA[i] = __builtin_amdgcn_exp2f(sA[i]); lA += sA[i]; }
        pA[0] = pack_frag(sA, 0); pA[1] = pack_frag(sA, 1);
        __builtin_amdgcn_sched_barrier(0);
#pragma unroll
        for (int i = 0; i < 16; ++i) { sB[i] = __builtin_amdgcn_exp2f(sB[i]); lB += sB[i]; }
        pB[0] = pack_frag(sB, 0); pB[1] = pack_frag(sB, 1); }
      const LAS unsigned char* vf = sb + vfr;
#pragma unroll
      for (int sk = 0; sk < 2; ++sk) {
#pragma unroll
        for (int dvt = 0; dvt < 4; ++dvt) { const bf16x8 a = *(const LAS bf16x8*)(vf + dvt * (32 * 128) + (((4 * st + 2 * sk + hh) ^ mv) << 4)); oA[dvt] = MFMA32(a, pA[sk], oA[dvt]); oB[dvt] = MFMA32(a, pB[sk], oB[dvt]); } }
    }
    asm volatile("s_waitcnt vmcnt(0)" ::: "memory");
    __syncthreads();
  }
  const int qrow_e = q0 + 64 * pr + (lane & 31) + opaque_zero();
  lA += shx(lA, 32); lB += shx(lB, 32);
  LAS float* xq = (LAS float*)lds + (size_t)pr * (64 * 132);
  if (sidx == 1) { const float iA = lam / lA, iB = lam / lB;
#pragma unroll
    for (int dvt = 0; dvt < 4; ++dvt)
#pragma unroll
      for (int g = 0; g < 4; ++g) { const int dv = 32 * dvt + 8 * g + 4 * hh;
        *(LAS f32x4*)(xq + r * 132 + dv) = (f32x4){oA[dvt][4 * g] * iA, oA[dvt][4 * g + 1] * iA, oA[dvt][4 * g + 2] * iA, oA[dvt][4 * g + 3] * iA};
        *(LAS f32x4*)(xq + (32 + r) * 132 + dv) = (f32x4){oB[dvt][4 * g] * iB, oB[dvt][4 * g + 1] * iB, oB[dvt][4 * g + 2] * iB, oB[dvt][4 * g + 3] * iB}; } }
  __syncthreads();
  if (sidx == 0) { const float iA = 1.f / lA, iB = 1.f / lB; float ssA = 0.f, ssB = 0.f;
#pragma unroll
    for (int dvt = 0; dvt < 4; ++dvt)
#pragma unroll
      for (int g = 0; g < 4; ++g) { const int dv = 32 * dvt + 8 * g + 4 * hh; const f32x4 xa = *(const LAS f32x4*)(xq + r * 132 + dv), xb = *(const LAS f32x4*)(xq + (32 + r) * 132 + dv);
#pragma unroll
        for (int e = 0; e < 4; ++e) { const float va = oA[dvt][4 * g + e] * iA - xa[e], vb = oB[dvt][4 * g + e] * iB - xb[e]; oA[dvt][4 * g + e] = va; oB[dvt][4 * g + e] = vb; ssA += va * va; ssB += vb * vb; }  }
    ssA += shx(ssA, 32); ssB += shx(ssB, 32);
    const float oml = __uint_as_float(__builtin_amdgcn_readfirstlane(__float_as_uint(1.f - lam_init)));
    const float rA = rsqrtf(ssA * (1.f / 128.f) + EPS) * oml, rB = rsqrtf(ssB * (1.f / 128.f) + EPS) * oml;
    const float* sg = P.in[12] + l * 128;
#pragma unroll
    for (int dvt = 0; dvt < 4; ++dvt)
#pragma unroll
      for (int g = 0; g < 4; ++g) { const int dv = 32 * dvt + 8 * g + 4 * hh; const f32x4 gv = *(const f32x4*)(sg + dv);
        u32x2 w; w.x = pk2(oA[dvt][4 * g] * rA * gv.x, oA[dvt][4 * g + 1] * rA * gv.y); w.y = pk2(oA[dvt][4 * g + 2] * rA * gv.z, oA[dvt][4 * g + 3] * rA * gv.w);
        *(u32x2*)(Yd + (size_t)qrow_e * 512 + h * 128 + dv) = w;
        u32x2 w2; w2.x = pk2(oB[dvt][4 * g] * rB * gv.x, oB[dvt][4 * g + 1] * rB * gv.y); w2.y = pk2(oB[dvt][4 * g + 2] * rB * gv.z, oB[dvt][4 * g + 3] * rB * gv.w);
        *(u32x2*)(Yd + (size_t)(qrow_e + 32) * 512 + h * 128 + dv) = w2; } }
  __syncthreads();
}
#ifndef ONLY
#define ONLY -1
#endif
#define ON(k) (ONLY < 0 || ONLY == (k))
__global__ void __launch_bounds__(512) mk_fwd(Params P) {
  extern __shared__ __attribute__((aligned(16))) unsigned char lds_raw[];
  LAS unsigned char* lds = (LAS unsigned char*)lds_raw;
  cg::grid_group grid = cg::this_grid();
  const int tid0 = threadIdx.x, G = gridDim.x, bx = blockIdx.x;
#define tid (tid0 + opaque_zero())
  unsigned char* ws = P.ws;
  const float* mod = (const float*)(ws + WS_MOD);
  bf16_t* A0 = (bf16_t*)(ws + WS_A0); bf16_t* Mb = A0; bf16_t* A1 = (bf16_t*)(ws + WS_Y);
  bf16_t* Zb = (bf16_t*)(ws + WS_Z); bf16_t* Hb = Zb; float* rss = (float*)(ws + WS_RSS);

  if (bx == 0) for (int i = tid; i < XCD_BAR_WORDS; i += 512) ((unsigned*)(ws + WS_BAR))[i] = 0u;
  if (ON(0)) phase_mod(P, lds, tid);
  if (ON(1)) phase_convert(P, lds, tid);
  grid.sync();
  volatile LAS unsigned* xst = (volatile LAS unsigned*)(lds + 147440);
  if (tid0 < 2) xst[tid0] = 0u;
  __syncthreads();
  const XcdBarrier xbar = xcd_barrier_post((unsigned*)(ws + WS_BAR), xst);
  for (int b = 0; b < 2; ++b) {
    float* xsLat = P.out + (size_t)b * TL * D; float* xsCtx = (float*)(ws + WS_XSC) + (size_t)b * CL * D;
    for (int l = 0; l < 2; ++l) {
      const bf16_t* WL = (const bf16_t*)(ws + WS_W + (size_t)l * WL_BYTES);
      const float* modl = mod + (size_t)l * 3 * NMOD;
      const int Mrest = (l == 0) ? RB : TL;
      if (l == 0) { if (b == 0 && ON(2)) phase_bias(P, tid); if (ON(3)) phase_prep(P, b, tid); xcd_barrier(xbar); }
      if (ON(4)) { pg8::Gemm g{A0, WL + OFF_WIN, RB, NZ, D}; pg8::StaticOrder S; S.init(RB, NZ, G, bx);
        EpiZ E{Zb, rss, (const float*)(ws + WS_BIN) + (size_t)l * 3 * NZ, b};
        pg8::gemm_phase<EpiZ, pg8::StaticOrder, true, true>(lds, g, S, E); }
      xcd_barrier(xbar);
      if (ON(5)) postproc_rows(P, l, tid);
      if (ON(6)) vt_items(P, lds, tid);
      __syncthreads();
      if (ON(7)) for (int u = bx; u < 8 * 260; u += G) gla_g1_unit(P, l, u, lds, tid);
      xcd_barrier(xbar);
      if (ON(8)) gla_scan(P, tid);
      if (ON(9)) { LAS float* rpbL = (LAS float*)lds; const float* rpb = P.in[18] + (size_t)l * 8 * 15 * 31;
        for (int i = tid; i < 8 * 15 * 31 + 128; i += 512) rpbL[i] = (i >= 64 && i < 64 + 8 * 15 * 31) ? rpb[i - 64] * LOG2E : 0.f;
        __syncthreads();
        const int nbu = (l == 0) ? 512 + 8 : 512;
        if ((G & 7) == 0) {
          const int per = (nbu + 7) >> 3, gx = G >> 3, xcd = bx & 7, li = bx >> 3;
          for (int jj = li; jj < per; jj += gx) { const int bu = xcd * per + jj; if (bu < nbu) na_block_unit(P, l, bu, lds, tid); }
        } else for (int bu = bx; bu < nbu; bu += G) na_block_unit(P, l, bu, lds, tid);
      }
      xcd_barrier(xbar);
      { const float* lp = P.in[11] + (size_t)l * 256; float d0 = 0.f, d1 = 0.f;
        for (int i = 0; i < 64; ++i) { d0 += lp[i] * lp[64 + i]; d1 += lp[128 + i] * lp[192 + i]; }
        const float lam_init_v = 0.8f - 0.6f * __expf(-0.3f * (float)l); const float lam_v = __expf(d0) - __expf(d1) + lam_init_v;
        const float lam_init = __uint_as_float(__builtin_amdgcn_readfirstlane(__float_as_uint(lam_init_v))), lam = __uint_as_float(__builtin_amdgcn_readfirstlane(__float_as_uint(lam_v)));
        const int nda = (l == 0) ? 260 : 256;
        if (ON(10)) for (int u = bx; u < nda; u += G) da_unit(P, l, u, lam, lam_init, lds, tid);
        __syncthreads();
        if (ON(11)) for (int u = bx; u < 4 * 260; u += G) { if (l == 1 && (u % 260) >= 256) continue; gla_g3_unit(P, l, u, lds, tid); }
      }
      xcd_barrier(xbar);
      if (ON(12)) for (int step = 0; step < 3; ++step) {
        const bf16_t* Yb = (const bf16_t*)(ws + WS_Y + (size_t)step * YB);
        pg8::Gemm g{Yb, WL + OFF_BR + (size_t)step * 524288, Mrest, D, 512}; pg8::StaticOrder S; S.init(Mrest, D, G, bx);
        EpiMerge E{Zb, Mb, step};
        pg8::gemm_phase<EpiMerge, pg8::StaticOrder, true, true>(lds, g, S, E);
      }
      xcd_barrier(xbar);
      if (ON(13)) { pg8::Gemm g{Mb, WL + OFF_OUT, Mrest, D, D}; pg8::StaticOrder S; S.init(Mrest, D, G, bx);
        const float* inLat = (l == 0) ? P.in[0] + (size_t)b * TL * D : xsLat; const float* inCtx = (l == 0) ? P.in[2] + (size_t)b * CL * D : xsCtx;
        EpiRes E{inLat, inCtx, xsLat, xsCtx, modl + 2048, P.in[7] + (size_t)l * D, modl + 4096, A1, rss, b};
        pg8::gemm_phase<EpiRes, pg8::StaticOrder, true, true>(lds, g, S, E); }
      xcd_barrier(xbar);
      unsigned* cflag = (unsigned*)(ws + WS_BAR) + 16 + 16 * b;
      const bool l0 = (l == 0) && G >= 64;
      const bool l0plain = (l == 0) && !l0;
      if (ON(14)) for (int pass = 0; pass < 2; ++pass) {
        pg8::Gemm g{A1, WL + OFF_W1, Mrest, FF, D}; pg8::StaticOrder S;
        if (pass == 0) S.init_one((l0 && bx >= 16 && bx < 32) ? 64 : -2, bx - 16);
        else if (l0) { if (bx < G - 4) S.init(TL, FF, G - 4, bx); else S.init_one(-2, 0); }
        else S.init(l0plain ? RB : TL, FF, G, bx);
        EpiF1 E{Hb, rss, (const float*)(ws + WS_BF1) + (size_t)l * 3 * FF, b};
        pg8::gemm_phase<EpiF1, pg8::StaticOrder, true, true>(lds, g, S, E);
        if (pass == 0 && l0 && bx >= 16 && bx < 32) {
          asm volatile("s_waitcnt vmcnt(0)" ::: "memory"); __syncthreads();
          if (threadIdx.x == 0) { __builtin_amdgcn_fence(__ATOMIC_RELEASE, "agent"); asm volatile("s_waitcnt vmcnt(0)" ::: "memory"); (void)xb_add(cflag, 1u); }
        }
      }
      if (ON(15)) for (int part = 0; part < 2; ++part) {
        pg8::Gemm g{Hb, WL + OFF_W2, Mrest, D, FF}; pg8::StaticOrder S;
        if (part == 0) {
          const bool mine = l0 && bx >= G - 4;
          if (mine) {
            if (threadIdx.x == 0) { unsigned sp = 0; while (xb_ld(cflag) < 16u && ++sp < (1u << 22)) __builtin_amdgcn_s_sleep(2);
              __builtin_amdgcn_fence(__ATOMIC_ACQUIRE, "agent"); asm volatile("s_waitcnt vmcnt(0)" ::: "memory"); }
            __syncthreads();
          }
          S.init_one(mine ? 64 : -2, bx - (G - 4));
        } else S.init(l0plain ? RB : TL, D, G, bx);
        EpiRes E{xsLat, xsCtx, xsLat, xsCtx, modl + 5120, (l == 0) ? P.in[6] + D : nullptr, mod + (size_t)3 * NMOD + 1024, (l == 0) ? A0 : nullptr, rss, b};
        pg8::gemm_phase<EpiRes, pg8::StaticOrder, true, true>(lds, g, S, E);
        if (part == 0) xcd_barrier(xbar);
      }
      if (!(b == 1 && l == 1)) xcd_barrier(xbar);
    }
  }
}

#undef tid
extern "C" void kernel_launch(void* const* d_in, const int* in_sizes, int n_in, void* d_out, int out_size, void* d_ws, size_t ws_size, hipStream_t stream) {
  static int grid = 0; constexpr int LDSB = 147456;
  if (grid == 0) {
    if (n_in != 25 || out_size != 2 * TL * D || ws_size < WS_END) { fprintf(stderr, "kernel_launch: unexpected problem (n_in %d out %d ws %zu need %zu)\n", n_in, out_size, ws_size, (size_t)WS_END); grid = -1; return; }
    int dev = 0, cus = 0, per = 0;
    (void)hipGetDevice(&dev); (void)hipDeviceGetAttribute(&cus, hipDeviceAttributeMultiprocessorCount, dev);
    (void)hipFuncSetAttribute((const void*)mk_fwd, hipFuncAttributeMaxDynamicSharedMemorySize, LDSB);
    (void)hipOccupancyMaxActiveBlocksPerMultiprocessor(&per, (const void*)mk_fwd, 512, LDSB);
    if (per < 1) per = 1;
    grid = cus * per;
  }
  if (grid < 0) return;
  Params p{};
  for (int i = 0; i < 25; ++i) p.in[i] = (const float*)d_in[i];
  p.out = (float*)d_out; p.ws = (unsigned char*)d_ws;
  void* args[] = {&p};
  hipError_t e = hipLaunchCooperativeKernel((const void*)mk_fwd, dim3(grid), dim3(512), args, LDSB, stream);
  if (e != hipSuccess) fprintf(stderr, "cooperative launch failed: %s (grid %d)\n", hipGetErrorString(e), grid);
}
```
